# Optimizing an MI355X kernel written in HIP

```python
import math
import jax, jax.numpy as jnp
from jax import lax
import numpy as np

D_MODEL = 1024
BATCH = 4
SEQ = 8192
DEPTH = 1

D_MIX = D_MODEL
RET_HEADS = 4
RET_HEAD_DIM = (D_MIX // 2) // RET_HEADS
RET_WIDTH = RET_HEADS * RET_HEAD_DIM
RET_CHUNK = 128
ATT_HEADS = 8
ATT_HEAD_DIM = (D_MIX - RET_WIDTH) // ATT_HEADS
ATT_WIDTH = ATT_HEADS * ATT_HEAD_DIM
DILATED_PATTERN = ((128, 1), (512, 4), (2048, 16))
BAND_BLOCK = 128
D_FF = 2816
ROPE_BASE = 10000.0
NORM_EPS = 1e-6
GN_EPS = 1e-6
IN_COLS = 4 * RET_WIDTH + 3 * ATT_WIDTH

kernel_name = "hybrid_retention_dilated_macaron"


def rms_norm(x, g):
    xf = x.astype(jnp.float32)
    y = xf * lax.rsqrt(jnp.mean(xf * xf, axis=-1, keepdims=True) + NORM_EPS)
    return (y * g.astype(jnp.float32)).astype(x.dtype)


def swiglu(x, w_gate, w_up, w_down):
    return (jax.nn.silu(x @ w_gate) * (x @ w_up)) @ w_down


def split_heads(t, n_heads):
    b, s, _ = t.shape
    return t.reshape(b, s, n_heads, -1).transpose(0, 2, 1, 3)


def rotate_every_two(t):
    t1 = t[..., ::2]
    t2 = t[..., 1::2]
    return jnp.stack((-t2, t1), axis=-1).reshape(t.shape)


def apply_rotary(t):
    s, d = t.shape[-2], t.shape[-1]
    pos = jnp.arange(s, dtype=jnp.float32)
    inv_freq = ROPE_BASE ** (-jnp.arange(0, d, 2, dtype=jnp.float32) / d)
    ang = jnp.repeat(pos[:, None] * inv_freq[None, :], 2, axis=-1)
    cos = jnp.cos(ang).astype(t.dtype)
    sin = jnp.sin(ang).astype(t.dtype)
    return t * cos + rotate_every_two(t) * sin


def chunkwise_retention(q, k, v):
    b, h, s, dk = q.shape
    dv = v.shape[-1]
    c = RET_CHUNK
    n = s // c
    dt = q.dtype
    log_g = jnp.log(1.0 - 2.0 ** (-5.0 - jnp.arange(h, dtype=jnp.float32)))
    idx = jnp.arange(c, dtype=jnp.float32)
    rel = idx[:, None] - idx[None, :]
    decay_in = jnp.where(rel >= 0, jnp.exp(log_g[:, None, None] * jnp.maximum(rel, 0.0)), 0.0)
    zeta = jnp.exp(log_g[:, None] * (c - 1 - idx)[None, :])
    xi = jnp.exp(log_g[:, None] * (idx + 1)[None, :])
    chunk_decay = jnp.exp(log_g * c)
    qc = q.reshape(b, h, n, c, dk)
    kc = k.reshape(b, h, n, c, dk)
    vc = v.reshape(b, h, n, c, dv)
    scores = jnp.einsum('bhncd,bhnmd->bhncm', qc, kc) * decay_in[None, :, None].astype(dt)
    intra = jnp.einsum('bhncm,bhnme->bhnce', scores, vc)
    kv = jnp.einsum('bhncd,bhnce->nbhde', kc * zeta[None, :, None, :, None].astype(dt), vc)
    gamma_c = chunk_decay[None, :, None, None].astype(dt)

    def step(state, kv_n):
        return state * gamma_c + kv_n, state

    _, prev_states = lax.scan(step, jnp.zeros((b, h, dk, dv), dt), kv)
    inter = jnp.einsum('bhncd,nbhde->bhnce', qc, prev_states) * xi[None, :, None, :, None].astype(dt)
    return (intra + inter).reshape(b, h, s, dv)


def dilated_window_branch(q, k, v, window, dilation):
    b, h, s, hd = q.shape
    L = s // dilation
    span = window // dilation
    blk = BAND_BLOCK
    nb = -(-L // blk)
    lp = nb * blk

    def to_blocks(t):
        t = t.reshape(b, h, L, dilation, hd).transpose(0, 1, 3, 2, 4)
        t = jnp.pad(t, ((0, 0), (0, 0), (0, 0), (0, lp - L), (0, 0)))
        return t.reshape(b, h, dilation, nb, blk, hd)

    def with_prev(t):
        prev = jnp.pad(t[:, :, :, :-1], ((0, 0), (0, 0), (0, 0), (1, 0), (0, 0), (0, 0)))
        return jnp.concatenate([prev, t], axis=4)

    qb = to_blocks(q)
    kb = with_prev(to_blocks(k))
    vb = with_prev(to_blocks(v))
    sc = jnp.einsum('bhgnqd,bhgnkd->bhgnqk', qb, kb).astype(jnp.float32)
    qi = jnp.arange(blk)[:, None]
    kj = jnp.arange(2 * blk)[None, :]
    dist = qi + blk - kj
    bidx = jnp.arange(nb)[:, None, None]
    mask = (dist >= 0) & (dist <= span) & (bidx * blk + kj - blk >= 0)
    sc = jnp.where(mask, sc, -jnp.inf)
    m = jnp.max(sc, axis=-1, keepdims=True)
    e = jnp.exp(sc - m)
    denom = jnp.sum(e, axis=-1, keepdims=True)
    lse = (m + jnp.log(denom))[..., 0]
    o = jnp.einsum('bhgnqk,bhgnkd->bhgnqd', (e / denom).astype(v.dtype), vb)
    o = o.reshape(b, h, dilation, lp, hd)[:, :, :, :L].transpose(0, 1, 3, 2, 4).reshape(b, h, s, hd)
    lse = lse.reshape(b, h, dilation, lp)[..., :L].transpose(0, 1, 3, 2).reshape(b, h, s)
    return o, lse


def dilated_attention(q, k, v):
    outs, lses = [], []
    for window, dilation in DILATED_PATTERN:
        o, l = dilated_window_branch(q, k, v, window, dilation)
        outs.append(o)
        lses.append(l)
    wts = jax.nn.softmax(jnp.stack(lses, axis=0), axis=0)
    return jnp.einsum('pbhs,pbhsd->bhsd', wts.astype(q.dtype), jnp.stack(outs, axis=0))


def setup_inputs(seed: int = 0) -> dict:
    key = jax.random.key(seed)
    ks = jax.random.split(key, 16)
    f32 = jnp.float32

    def w(k_, shape, fan_in):
        return jax.random.normal(k_, shape, f32) * (fan_in ** -0.5)

    def gain(k_, shape):
        return 1.0 + 0.02 * jax.random.normal(k_, shape, f32)

    return {
        "x": jax.random.normal(ks[0], (BATCH, SEQ, D_MODEL), f32),
        "norm_ffn1": gain(ks[1], (DEPTH, D_MODEL)),
        "ffn1_w_gate": w(ks[2], (DEPTH, D_MODEL, D_FF), D_MODEL),
        "ffn1_w_up": w(ks[3], (DEPTH, D_MODEL, D_FF), D_MODEL),
        "ffn1_w_down": w(ks[4], (DEPTH, D_FF, D_MODEL), D_FF),
        "norm_mix": gain(ks[5], (DEPTH, D_MODEL)),
        "w_in": w(ks[6], (DEPTH, D_MODEL, IN_COLS), D_MODEL),
        "ret_norm_gain": gain(ks[7], (DEPTH, RET_WIDTH)),
        "w_out": w(ks[8], (DEPTH, D_MIX, D_MODEL), D_MIX),
        "norm_ffn2": gain(ks[9], (DEPTH, D_MODEL)),
        "ffn2_w_gate": w(ks[10], (DEPTH, D_MODEL, D_FF), D_MODEL),
        "ffn2_w_up": w(ks[11], (DEPTH, D_MODEL, D_FF), D_MODEL),
        "ffn2_w_down": w(ks[12], (DEPTH, D_FF, D_MODEL), D_FF),
        "norm_final": gain(ks[13], (D_MODEL,)),
    }


def reference(x, norm_ffn1, ffn1_w_gate, ffn1_w_up, ffn1_w_down, norm_mix, w_in, ret_norm_gain,
              w_out, norm_ffn2, ffn2_w_gate, ffn2_w_up, ffn2_w_down, norm_final):
    b, s, _ = x.shape
    h = x
    for l in range(DEPTH):
        h = h + 0.5 * swiglu(rms_norm(h, norm_ffn1[l]), ffn1_w_gate[l], ffn1_w_up[l], ffn1_w_down[l])

        u = rms_norm(h, norm_mix[l]) @ w_in[l]
        rq, rk, rv, rg, aq, ak, av = jnp.split(
            u, np.cumsum([RET_WIDTH] * 4 + [ATT_WIDTH] * 2).tolist(), axis=-1)

        rq = apply_rotary(split_heads(rq, RET_HEADS))
        rk = apply_rotary(split_heads(rk, RET_HEADS)) * (RET_HEAD_DIM ** -0.5)
        ret = chunkwise_retention(rq, rk, split_heads(rv, RET_HEADS)).astype(jnp.float32)
        mu = jnp.mean(ret, axis=-1, keepdims=True)
        var = jnp.mean(jnp.square(ret - mu), axis=-1, keepdims=True)
        ret = ((ret - mu) * lax.rsqrt(var + GN_EPS)).transpose(0, 2, 1, 3).reshape(b, s, RET_WIDTH)
        ret = (ret * ret_norm_gain[l].astype(jnp.float32)).astype(x.dtype) * jax.nn.silu(rg)

        att = dilated_attention(split_heads(aq, ATT_HEADS) * (ATT_HEAD_DIM ** -0.5),
                                split_heads(ak, ATT_HEADS), split_heads(av, ATT_HEADS))
        att = att.transpose(0, 2, 1, 3).reshape(b, s, ATT_WIDTH)

        h = h + jnp.concatenate([ret, att], axis=-1) @ w_out[l]

        h = h + 0.5 * swiglu(rms_norm(h, norm_ffn2[l]), ffn2_w_gate[l], ffn2_w_up[l], ffn2_w_down[l])
    return rms_norm(h, norm_final)
```

```cpp
#include <hip/hip_runtime.h>
#include <cstdio>
#include <cstdint>

constexpr int BATCH = 4, SEQ = 8192, DM = 1024, DFF = 2816, NIN = 3584;

__device__ __forceinline__ float wave_sum(float v) {
#pragma unroll
    for (int o = 1; o < 64; o <<= 1) v += __shfl_xor(v, o);
    return v;
}

__global__ __launch_bounds__(256) void rmsnorm_k(const float* in, const float* g, float* out, int rows) {
    const int row = blockIdx.x * 4 + (threadIdx.x >> 6), lane = threadIdx.x & 63;
    if (row >= rows) return;
    const float* x = in + (size_t)row * DM;
    float v[16]; float s = 0.f;
#pragma unroll
    for (int j = 0; j < 16; ++j) { v[j] = x[lane + 64 * j]; s += v[j] * v[j]; }
    s = wave_sum(s);
    const float r = 1.0f / sqrtf(s * (1.0f / DM) + 1e-6f);
#pragma unroll
    for (int j = 0; j < 16; ++j) out[(size_t)row * DM + lane + 64 * j] = v[j] * r * g[lane + 64 * j];
}

__device__ __forceinline__ float silu_f(float x) { return x / (1.0f + expf(-x)); }

template <int MODE>
__global__ __launch_bounds__(256) void gemm_f32(const float* A, const float* W, const float* W2, float* C, const float* R, float alpha, int M, int N, int K) {
    __shared__ float As[16][68];
    __shared__ float Bs[16][68];
    __shared__ float Bs2[16][68];
    const int tid = threadIdx.x, tx = tid & 15, ty = tid >> 4;
    const int m0 = blockIdx.y * 64, n0 = blockIdx.x * 64;
    float acc[4][4], acc2[4][4];
#pragma unroll
    for (int i = 0; i < 4; ++i)
#pragma unroll
        for (int j = 0; j < 4; ++j) { acc[i][j] = 0.f; acc2[i][j] = 0.f; }
    for (int k0 = 0; k0 < K; k0 += 16) {
        {
            const int r = tid >> 2, c = (tid & 3) * 4;
            const float4 a = *(const float4*)(A + (size_t)(m0 + r) * K + k0 + c);
            As[c + 0][r] = a.x; As[c + 1][r] = a.y; As[c + 2][r] = a.z; As[c + 3][r] = a.w;
            const int kr = tid >> 4, nc = (tid & 15) * 4;
            const float4 b = *(const float4*)(W + (size_t)(k0 + kr) * N + n0 + nc);
            Bs[kr][nc + 0] = b.x; Bs[kr][nc + 1] = b.y; Bs[kr][nc + 2] = b.z; Bs[kr][nc + 3] = b.w;
            if (MODE == 2) {
                const float4 b2 = *(const float4*)(W2 + (size_t)(k0 + kr) * N + n0 + nc);
                Bs2[kr][nc + 0] = b2.x; Bs2[kr][nc + 1] = b2.y; Bs2[kr][nc + 2] = b2.z; Bs2[kr][nc + 3] = b2.w;
            }
        }
        __syncthreads();
#pragma unroll
        for (int k = 0; k < 16; ++k) {
            float a[4], b[4], b2[4];
#pragma unroll
            for (int i = 0; i < 4; ++i) a[i] = As[k][ty * 4 + i];
#pragma unroll
            for (int j = 0; j < 4; ++j) { b[j] = Bs[k][tx * 4 + j]; if (MODE == 2) b2[j] = Bs2[k][tx * 4 + j]; }
#pragma unroll
            for (int i = 0; i < 4; ++i)
#pragma unroll
                for (int j = 0; j < 4; ++j) { acc[i][j] += a[i] * b[j]; if (MODE == 2) acc2[i][j] += a[i] * b2[j]; }
        }
        __syncthreads();
    }
#pragma unroll
    for (int i = 0; i < 4; ++i)
#pragma unroll
        for (int j = 0; j < 4; ++j) {
            const size_t idx = (size_t)(m0 + ty * 4 + i) * N + n0 + tx * 4 + j;
            float v = acc[i][j];
            if (MODE == 1) v = R[idx] + alpha * v;
            if (MODE == 2) v = silu_f(v) * acc2[i][j];
            C[idx] = v;
        }
}

__global__ __launch_bounds__(256) void rotary_k(float* u) {
    const int gid = blockIdx.x * 256 + threadIdx.x;
    const int s = gid >> 8, pr = gid & 255, h = pr >> 6, i = pr & 63;
    if (s >= SEQ) return;
    const float inv = powf(10000.0f, -(float)(2 * i) / 128.0f);
    const float ang = (float)s * inv;
    const float c = cosf(ang), sn = sinf(ang);
    float* row = u + (size_t)s * NIN;
    {
        float* p = row + h * 128 + 2 * i; const float a = p[0], b = p[1];
        p[0] = a * c - b * sn; p[1] = b * c + a * sn;
    }
    {
        float* p = row + 512 + h * 128 + 2 * i; const float a = p[0], b = p[1];
        p[0] = (a * c - b * sn) * 0.08838834764831845f; p[1] = (b * c + a * sn) * 0.08838834764831845f;
    }
    {
        float* p = row + 2048 + pr * 2; p[0] *= 0.125f; p[1] *= 0.125f;
    }
}

__global__ __launch_bounds__(1024) void ret_recur(const float* u, float* ret) {
    const int h = blockIdx.x, e = threadIdx.x & 127, dg = threadIdx.x >> 7;
    const float gamma = 1.0f - exp2f(-5.0f - (float)h);
    float st[16];
#pragma unroll
    for (int i = 0; i < 16; ++i) st[i] = 0.f;
    __shared__ float part[2][8][128];
    for (int t = 0; t < SEQ; ++t) {
        const float* row = u + (size_t)t * NIN;
        const float v = row[1024 + h * 128 + e];
        float o = 0.f;
#pragma unroll
        for (int i4 = 0; i4 < 4; ++i4) {
            const float4 k4 = *(const float4*)(row + 512 + h * 128 + 16 * dg + 4 * i4);
            const float4 q4 = *(const float4*)(row + h * 128 + 16 * dg + 4 * i4);
            st[4 * i4 + 0] = gamma * st[4 * i4 + 0] + k4.x * v; o += q4.x * st[4 * i4 + 0];
            st[4 * i4 + 1] = gamma * st[4 * i4 + 1] + k4.y * v; o += q4.y * st[4 * i4 + 1];
            st[4 * i4 + 2] = gamma * st[4 * i4 + 2] + k4.z * v; o += q4.z * st[4 * i4 + 2];
            st[4 * i4 + 3] = gamma * st[4 * i4 + 3] + k4.w * v; o += q4.w * st[4 * i4 + 3];
        }
        part[t & 1][dg][e] = o;
        __syncthreads();
        if (dg == 0) {
            float s = 0.f;
#pragma unroll
            for (int g = 0; g < 8; ++g) s += part[t & 1][g][e];
            ret[(size_t)t * 512 + h * 128 + e] = s;
        }
    }
}

__global__ __launch_bounds__(256) void gn_gate_k(const float* ret, const float* u, const float* gain, float* mix) {
    const int w = blockIdx.x * 4 + (threadIdx.x >> 6), lane = threadIdx.x & 63;
    const int t = w >> 2, h = w & 3;
    if (t >= SEQ) return;
    const float a = ret[(size_t)t * 512 + h * 128 + lane], b = ret[(size_t)t * 512 + h * 128 + 64 + lane];
    const float mu = wave_sum(a + b) * (1.0f / 128.0f);
    const float da = a - mu, db = b - mu;
    const float var = wave_sum(da * da + db * db) * (1.0f / 128.0f);
    const float r = 1.0f / sqrtf(var + 1e-6f);
    const float g0 = u[(size_t)t * NIN + 1536 + h * 128 + lane], g1 = u[(size_t)t * NIN + 1536 + h * 128 + 64 + lane];
    mix[(size_t)t * DM + h * 128 + lane] = da * r * gain[h * 128 + lane] * silu_f(g0);
    mix[(size_t)t * DM + h * 128 + 64 + lane] = db * r * gain[h * 128 + 64 + lane] * silu_f(g1);
}

__global__ __launch_bounds__(256) void attn_naive(const float* u, float* mix) {
    const int w = blockIdx.x * 4 + (threadIdx.x >> 6), lane = threadIdx.x & 63;
    const int t = w >> 3, h = w & 7;
    if (t >= SEQ) return;
    const float q = u[(size_t)t * NIN + 2048 + h * 64 + lane];
    float lse[3], op[3];
#pragma unroll
    for (int p = 0; p < 3; ++p) {
        const int dil = (p == 0) ? 1 : (p == 1) ? 4 : 16;
        float m = -INFINITY, l = 0.f, o = 0.f;
        for (int dist = 0; dist <= 128; ++dist) {
            const int tk = t - dil * dist;
            if (tk < 0) break;
            const float k = u[(size_t)tk * NIN + 2560 + h * 64 + lane];
            const float v = u[(size_t)tk * NIN + 3072 + h * 64 + lane];
            const float s = wave_sum(q * k);
            const float mn = fmaxf(m, s);
            const float a = expf(m - mn), pe = expf(s - mn);
            l = l * a + pe; o = o * a + pe * v; m = mn;
        }
        lse[p] = m + logf(l); op[p] = o / l;
    }
    const float M = fmaxf(lse[0], fmaxf(lse[1], lse[2]));
    const float w0 = expf(lse[0] - M), w1 = expf(lse[1] - M), w2 = expf(lse[2] - M);
    mix[(size_t)t * DM + 512 + h * 64 + lane] = (w0 * op[0] + w1 * op[1] + w2 * op[2]) / (w0 + w1 + w2);
}

extern "C" void kernel_launch(void* const* d_in, const int* in_sizes, int n_in, void* d_out, int out_size, void* d_ws, size_t ws_size, hipStream_t stream) {
    const float* x = (const float*)d_in[0];
    const float* g1 = (const float*)d_in[1];
    const float* wg1 = (const float*)d_in[2];
    const float* wu1 = (const float*)d_in[3];
    const float* wd1 = (const float*)d_in[4];
    const float* gmix = (const float*)d_in[5];
    const float* win = (const float*)d_in[6];
    const float* rgain = (const float*)d_in[7];
    const float* wout = (const float*)d_in[8];
    const float* g2 = (const float*)d_in[9];
    const float* wg2 = (const float*)d_in[10];
    const float* wu2 = (const float*)d_in[11];
    const float* wd2 = (const float*)d_in[12];
    const float* gfin = (const float*)d_in[13];
    constexpr size_t MiB = 1u << 20;
    if (ws_size < 300 * MiB) { fprintf(stderr, "ws too small\n"); return; }
    char* ws = (char*)d_ws;
    float* xn = (float*)(ws);
    float* act = (float*)(ws + 32 * MiB);
    float* u = (float*)(ws + 120 * MiB);
    float* ret = (float*)(ws + 232 * MiB);
    float* mix = (float*)(ws + 248 * MiB);
    for (int b = 0; b < BATCH; ++b) {
        const float* xb = x + (size_t)b * SEQ * DM;
        float* hb = (float*)d_out + (size_t)b * SEQ * DM;
        rmsnorm_k<<<SEQ / 4, 256, 0, stream>>>(xb, g1, xn, SEQ);
        gemm_f32<2><<<dim3(DFF / 64, SEQ / 64), 256, 0, stream>>>(xn, wg1, wu1, act, nullptr, 0.f, SEQ, DFF, DM);
        gemm_f32<1><<<dim3(DM / 64, SEQ / 64), 256, 0, stream>>>(act, wd1, nullptr, hb, xb, 0.5f, SEQ, DM, DFF);
        rmsnorm_k<<<SEQ / 4, 256, 0, stream>>>(hb, gmix, xn, SEQ);
        gemm_f32<0><<<dim3(NIN / 64, SEQ / 64), 256, 0, stream>>>(xn, win, nullptr, u, nullptr, 0.f, SEQ, NIN, DM);
        rotary_k<<<SEQ, 256, 0, stream>>>(u);
        ret_recur<<<4, 1024, 0, stream>>>(u, ret);
        gn_gate_k<<<SEQ, 256, 0, stream>>>(ret, u, rgain, mix);
        attn_naive<<<SEQ * 2, 256, 0, stream>>>(u, mix);
        gemm_f32<1><<<dim3(DM / 64, SEQ / 64), 256, 0, stream>>>(mix, wout, nullptr, hb, hb, 1.0f, SEQ, DM, DM);
        rmsnorm_k<<<SEQ / 4, 256, 0, stream>>>(hb, g2, xn, SEQ);
        gemm_f32<2><<<dim3(DFF / 64, SEQ / 64), 256, 0, stream>>>(xn, wg2, wu2, act, nullptr, 0.f, SEQ, DFF, DM);
        gemm_f32<1><<<dim3(DM / 64, SEQ / 64), 256, 0, stream>>>(act, wd2, nullptr, hb, hb, 0.5f, SEQ, DM, DFF);
        rmsnorm_k<<<SEQ / 4, 256, 0, stream>>>(hb, gfin, hb, SEQ);
    }
}
```

```cpp
#include <hip/hip_runtime.h>
#include <cstdio>
#include <cstdint>
#include <cmath>
namespace pg8 {
#define PG8_LAS __attribute__((address_space(3)))
typedef unsigned short bf16_t;
typedef short bf16x8 __attribute__((ext_vector_type(8)));
typedef float f32x4 __attribute__((ext_vector_type(4)));
typedef unsigned u32x4 __attribute__((ext_vector_type(4)));
constexpr int BM = 256, BK = 64, HALF = 128, HTB = HALF * BK * 2  , STAGE_BYTES = 8 * HTB, NXCD = 8, WGM = 8;

__host__ __device__ __forceinline__ int lds_byte(int r, int c) { const int st = (r >> 4) * 2 + (c >> 5), rr = r & 15, cc = c & 31, ob = rr * 64 + cc * 2; return st * 1024 + (ob ^ (((ob >> 9) & 1) << 5)); }
__host__ __device__ __forceinline__ void stage_rc(int b, int& R, int& C) { const int st = b / 1024, sb = b % 1024, swz = sb ^ (((sb >> 9) & 1) << 5); R = (st >> 1) * 16 + swz / 64; C = (st & 1) * 32 + (swz % 64) / 2; }
__host__ __device__ __forceinline__ int perm32(int rho) { const int n = rho >> 4, i = rho & 15; return 8 * (i >> 2) + 4 * n + (i & 3); }

struct Unit { int pm, pn; };
struct Gemm { const bf16_t* A; const bf16_t* Bt; int M, N, K; };

struct StaticOrder {
    int nM, nN, nwg, G, c;
    __host__ __device__ void init(int M, int N, int G_, int c_) { nM = M / BM; nN = N / BM; nwg = nM * nN; G = G_; c = c_; }
    __host__ __device__ bool next(int i, Unit& u) const {
        const long L = (long)i * G + c; if (L >= nwg) return false;
        int wgid = (int)L; { const int q = nwg / NXCD, r = nwg % NXCD, xcd = wgid % NXCD, off = wgid / NXCD; wgid = (xcd < r ? xcd * (q + 1) : r * (q + 1) + (xcd - r) * q) + off; }
        const int nig = WGM * nN, gid = wgid / nig, fm = gid * WGM, gsz = (nM - fm) < WGM ? (nM - fm) : WGM;
        u.pm = fm + ((wgid % nig) % gsz); u.pn = (wgid % nig) / gsz; return true;
    }
    __device__ __forceinline__ void a_ready(const Unit&) const {}
    __device__ __forceinline__ void done(const Unit&) const {}
};

__device__ __forceinline__ unsigned cvt_pk_bf16(float lo, float hi) { unsigned r; asm volatile("v_cvt_pk_bf16_f32 %0, %1, %2" : "=v"(r) : "v"(lo), "v"(hi)); return r; }
typedef float f32x2 __attribute__((ext_vector_type(2)));
__device__ __forceinline__ float fast_rcp(float x) { return __builtin_amdgcn_rcpf(x); }
__device__ __forceinline__ float silu_fast(float v) { return v * fast_rcp(1.0f + __builtin_amdgcn_exp2f(-1.4426950408889634f * v)); }
__device__ __forceinline__ float row_rs(const float* ss, int row) { return 1.0f / sqrtf(ss[row] * (1.0f / 1024.0f) + 1e-6f); }

struct EpiSwiGLU {
    static constexpr bool PERM = true, AFTER_DRAIN = false;
    bf16_t* O; int ldc; const float* ss;
    __device__ __forceinline__ void operator()(const f32x4 (&acc)[2][2][4][2], const Unit& u, int wr, int wc, int fr, int fq) const {
        const int row0 = u.pm * BM + wr * 64 + fr, col0 = u.pn * HALF + wc * 32 + 8 * fq;
#pragma unroll
        for (int ai = 0; ai < 2; ++ai)
#pragma unroll
            for (int m = 0; m < 4; ++m) {
                const int row = row0 + ai * HALF + m * 16; const float rs = row_rs(ss, row);
                const f32x4 g0 = acc[ai][0][m][0] * rs, g1 = acc[ai][0][m][1] * rs, u0 = acc[ai][1][m][0] * rs, u1 = acc[ai][1][m][1] * rs;
                u32x4 w;
                w.x = cvt_pk_bf16(silu_fast(g0[0]) * u0[0], silu_fast(g0[1]) * u0[1]); w.y = cvt_pk_bf16(silu_fast(g0[2]) * u0[2], silu_fast(g0[3]) * u0[3]);
                w.z = cvt_pk_bf16(silu_fast(g1[0]) * u1[0], silu_fast(g1[1]) * u1[1]); w.w = cvt_pk_bf16(silu_fast(g1[2]) * u1[2], silu_fast(g1[3]) * u1[3]);
                *(u32x4*)(O + (size_t)row * ldc + col0) = w;
            }
    }
};

template <bool WITH_BF16> struct EpiResid {
    static constexpr bool PERM = false, AFTER_DRAIN = false;
    const float* base; float* out; bf16_t* ob; float alpha; float* ss;
    __device__ __forceinline__ void operator()(const f32x4 (&acc)[2][2][4][2], const Unit& u, int wr, int wc, int fr, int fq) const {
        typedef unsigned u32x2v __attribute__((ext_vector_type(2)));
        const int row0 = u.pm * BM + wr * 64 + fr, col0 = u.pn * BM + wc * 32 + 4 * fq;
#pragma unroll
        for (int ai = 0; ai < 2; ++ai)
#pragma unroll
            for (int m = 0; m < 4; ++m) {
                const int row = row0 + ai * HALF + m * 16; const size_t off = (size_t)row * 1024 + col0; float sq = 0.f;
#pragma unroll
                for (int bj = 0; bj < 2; ++bj)
#pragma unroll
                    for (int n = 0; n < 2; ++n) {
                        const f32x4 b = *(const f32x4*)(base + off + bj * HALF + n * 16);
                        const f32x4 o = b + acc[ai][bj][m][n] * alpha;
                        *(f32x4*)(out + off + bj * HALF + n * 16) = o;
                        sq += (o[0] * o[0] + o[1] * o[1]) + (o[2] * o[2] + o[3] * o[3]);
                        if (WITH_BF16) { u32x2v w; w.x = cvt_pk_bf16(o[0], o[1]); w.y = cvt_pk_bf16(o[2], o[3]); *(u32x2v*)(ob + off + bj * HALF + n * 16) = w; }
                    }
                sq += __shfl_xor(sq, 16); sq += __shfl_xor(sq, 32);
                if (fq == 0) (void)__hip_atomic_fetch_add(ss + row, sq, __ATOMIC_RELAXED, __HIP_MEMORY_SCOPE_AGENT);
                asm volatile("" ::: "memory");
            }
    }
};

struct EpiUProj {
    static constexpr bool PERM = true, AFTER_DRAIN = false;
    bf16_t* U; const float* ss; const float* cosT; const float* sinT;
    __device__ __forceinline__ void operator()(const f32x4 (&acc)[2][2][4][2], const Unit& u, int wr, int wc, int fr, int fq) const {
        const int row0 = u.pm * BM + wr * 64 + fr, col0 = u.pn * BM + wc * 32 + 8 * fq;
        const bool rot = u.pn < 4;
        const float sc = (u.pn == 2 || u.pn == 3) ? 0.08838834764831845f : ((u.pn == 8 || u.pn == 9) ? 0.125f : 1.0f);
#pragma unroll
        for (int ai = 0; ai < 2; ++ai)
#pragma unroll
            for (int m = 0; m < 4; ++m) {
                const int row = row0 + ai * HALF + m * 16; const float rs = row_rs(ss, row) * sc;
                f32x4 c4 = (f32x4){1.f, 1.f, 1.f, 1.f}, s4 = (f32x4){0.f, 0.f, 0.f, 0.f};
                if (rot) { const int pos = row & 8191; c4 = *(const f32x4*)(cosT + pos * 64 + 16 * wc + 4 * fq); s4 = *(const f32x4*)(sinT + pos * 64 + 16 * wc + 4 * fq); }
#pragma unroll
                for (int bj = 0; bj < 2; ++bj) {
                    const f32x4 v0 = acc[ai][bj][m][0] * rs, v1 = acc[ai][bj][m][1] * rs;
                    u32x4 w;
                    w.x = cvt_pk_bf16(v0[0] * c4[0] - v0[1] * s4[0], v0[1] * c4[0] + v0[0] * s4[0]);
                    w.y = cvt_pk_bf16(v0[2] * c4[1] - v0[3] * s4[1], v0[3] * c4[1] + v0[2] * s4[1]);
                    w.z = cvt_pk_bf16(v1[0] * c4[2] - v1[1] * s4[2], v1[1] * c4[2] + v1[0] * s4[2]);
                    w.w = cvt_pk_bf16(v1[2] * c4[3] - v1[3] * s4[3], v1[3] * c4[3] + v1[2] * s4[3]);
                    *(u32x4*)(U + (size_t)row * 3584 + col0 + bj * HALF) = w;
                }
            }
    }
};
template <class Epi, class Sched, bool ALIGN_EPI = false, bool SP2 = false>
__device__ __forceinline__ void gemm_phase(PG8_LAS unsigned char* lds, const Gemm g, const Sched& S, const Epi& E) {
    const int tid = threadIdx.x, wid = __builtin_amdgcn_readfirstlane(tid >> 6), lane = tid & 63, wr = wid >> 2, wc = wid & 3, fr = lane & 15, fq = lane >> 4;
    const int K = g.K, nt = K / BK;
    unsigned voffA[2], voffB[2];
#pragma unroll
    for (int i = 0; i < 2; ++i) { int R, C; stage_rc(tid * 16 + i * 8192, R, C); const int Rb = Epi::PERM ? ((R & ~31) + perm32(R & 31)) : R;
        voffA[i] = (unsigned)(R * K + C) * 2u; voffB[i] = (unsigned)(Rb * K + C) * 2u; }
    const size_t kstep = (size_t)(BK * 2);
    const size_t hstep = (size_t)HALF * K * 2;
    const size_t tstep = 2 * hstep;
    const unsigned ldsw = (unsigned)wid * 1024u;
    const int aoff = lds_byte(wr * 64 + fr, fq * 8), boff = lds_byte(wc * 32 + fr, fq * 8);
#define PG8_SA(b, h) (((b) * 2 + (h)) * HTB)
#define PG8_SB(b, h) ((4 + (b) * 2 + (h)) * HTB)
#define PG8_STAGE(bufoff, gbase, voff) do { _Pragma("unroll") for (int _i = 0; _i < 2; ++_i) \
        __builtin_amdgcn_global_load_lds((const unsigned*)((const char*)(gbase) + (voff)[_i]), (PG8_LAS unsigned*)(lds + (bufoff) + ldsw + _i * 8192), 16, 0, 0); } while (0)
#define PG8_LDA(dst, b, h) do { _Pragma("unroll") for (int m = 0; m < 4; ++m) _Pragma("unroll") for (int k = 0; k < 2; ++k) dst[m][k] = *(const PG8_LAS bf16x8*)(lds + PG8_SA(b, h) + aoff + m * 2048 + k * 1024); } while (0)
#define PG8_LDB(dst, b, h) do { _Pragma("unroll") for (int n = 0; n < 2; ++n) _Pragma("unroll") for (int k = 0; k < 2; ++k) dst[n][k] = *(const PG8_LAS bf16x8*)(lds + PG8_SB(b, h) + boff + n * 2048 + k * 1024); } while (0)
#define PG8_MMA(ai, bj, At, Bt) do { __builtin_amdgcn_s_setprio(1); _Pragma("unroll") for (int m = 0; m < 4; ++m) _Pragma("unroll") for (int n = 0; n < 2; ++n) _Pragma("unroll") for (int k = 0; k < 2; ++k) \
        acc[ai][bj][m][n] = __builtin_amdgcn_mfma_f32_16x16x32_bf16(Bt[n][k], At[m][k], acc[ai][bj][m][n], 0, 0, 0); __builtin_amdgcn_s_setprio(0); } while (0)
#define PG8_WAIT_V(n) asm volatile("s_waitcnt vmcnt(" #n ")" ::: "memory")
#define PG8_WAIT_L(n) asm volatile("s_waitcnt lgkmcnt(" #n ")" ::: "memory")
#define PG8_BAR __builtin_amdgcn_s_barrier()
#define PG8_SCHED __builtin_amdgcn_sched_barrier(0)
    Unit cur, nxt; int ui = 0;
    if (!S.next(0, cur)) return;
    f32x4 acc[2][2][4][2];
#pragma unroll
    for (int a = 0; a < 2; ++a)
#pragma unroll
        for (int b = 0; b < 2; ++b)
#pragma unroll
            for (int m = 0; m < 4; ++m)
#pragma unroll
                for (int n = 0; n < 2; ++n) acc[a][b][m][n] = (f32x4){0.f, 0.f, 0.f, 0.f};
    bf16x8 At[4][2], B0[2][2], B1[2][2];
    const char* cA = (const char*)g.A + (size_t)cur.pm * tstep; const char* cB = (const char*)g.Bt + (size_t)cur.pn * tstep;
    S.a_ready(cur);
    if constexpr (SP2) {
        PG8_STAGE(PG8_SB(0, 0), cB, voffB); PG8_STAGE(PG8_SB(0, 1), cB + hstep, voffB); PG8_STAGE(PG8_SA(0, 0), cA, voffA); PG8_STAGE(PG8_SA(0, 1), cA + hstep, voffA);
        if (wr == 1) PG8_BAR;
        PG8_WAIT_V(2); PG8_BAR;
        PG8_STAGE(PG8_SB(1, 0), cB + kstep, voffB); PG8_STAGE(PG8_SA(1, 0), cA + kstep, voffA); PG8_STAGE(PG8_SB(1, 1), cB + hstep + kstep, voffB);
        PG8_WAIT_V(6); PG8_BAR;
    } else {
        PG8_STAGE(PG8_SB(0, 0), cB, voffB); PG8_STAGE(PG8_SA(0, 0), cA, voffA); PG8_STAGE(PG8_SB(0, 1), cB + hstep, voffB); PG8_STAGE(PG8_SA(0, 1), cA + hstep, voffA);
        if (wr == 1) PG8_BAR;
        PG8_WAIT_V(4); PG8_BAR;
        PG8_STAGE(PG8_SB(1, 0), cB + kstep, voffB); PG8_STAGE(PG8_SA(1, 0), cA + kstep, voffA); PG8_STAGE(PG8_SB(1, 1), cB + hstep + kstep, voffB);
        PG8_WAIT_V(6); PG8_BAR;
    }
    for (;;) {
        const bool has_next = S.next(ui + 1, nxt);
        const char* nA = has_next ? (const char*)g.A + (size_t)nxt.pm * tstep : cA; const char* nB = has_next ? (const char*)g.Bt + (size_t)nxt.pn * tstep : cB;
        for (int t = 0; t < nt; t += 2) {
            const bool last = (t == nt - 2);
            const char* a1 = cA + (size_t)(t + 1) * kstep;
            const char* a2 = last ? nA : cA + (size_t)(t + 2) * kstep; const char* b2 = last ? nB : cB + (size_t)(t + 2) * kstep;
            const char* a3 = a2 + kstep; const char* b3 = b2 + kstep;
            if (last && has_next) S.a_ready(nxt);
            if constexpr (SP2) {
            PG8_LDB(B0, 0, 0); PG8_LDB(B1, 0, 1); PG8_SCHED; PG8_LDA(At, 0, 0); PG8_STAGE(PG8_SA(1, 1), a1 + hstep, voffA);
            PG8_WAIT_V(8); PG8_WAIT_L(0); PG8_BAR; PG8_MMA(0, 0, At, B0); PG8_MMA(0, 1, At, B1); PG8_BAR; PG8_SCHED;
            PG8_LDA(At, 0, 1); PG8_STAGE(PG8_SB(0, 0), b2, voffB); PG8_STAGE(PG8_SB(0, 1), b2 + hstep, voffB); PG8_STAGE(PG8_SA(0, 0), a2, voffA);
            PG8_WAIT_V(8); PG8_WAIT_L(0); PG8_BAR; PG8_MMA(1, 0, At, B0); PG8_MMA(1, 1, At, B1); PG8_BAR; PG8_SCHED;
            PG8_LDB(B0, 1, 0); PG8_LDB(B1, 1, 1); PG8_SCHED; PG8_LDA(At, 1, 0); PG8_STAGE(PG8_SA(0, 1), a2 + hstep, voffA);
            PG8_WAIT_V(8); PG8_WAIT_L(0); PG8_BAR; PG8_MMA(0, 0, At, B0); PG8_MMA(0, 1, At, B1); PG8_BAR; PG8_SCHED;
            PG8_LDA(At, 1, 1); PG8_STAGE(PG8_SB(1, 0), b3, voffB); PG8_STAGE(PG8_SB(1, 1), b3 + hstep, voffB); PG8_STAGE(PG8_SA(1, 0), a3, voffA);
            PG8_WAIT_V(8); PG8_WAIT_L(0); PG8_BAR; PG8_MMA(1, 0, At, B0); PG8_MMA(1, 1, At, B1); PG8_BAR; PG8_SCHED;
            } else {
            PG8_LDB(B0, 0, 0); PG8_SCHED; PG8_LDA(At, 0, 0); PG8_STAGE(PG8_SA(1, 1), a1 + hstep, voffA);
            PG8_WAIT_L(8); PG8_BAR; PG8_WAIT_L(0); PG8_MMA(0, 0, At, B0); PG8_BAR; PG8_SCHED;
            PG8_LDB(B1, 0, 1); PG8_STAGE(PG8_SB(0, 0), b2, voffB);
            PG8_BAR; PG8_WAIT_L(0); PG8_MMA(0, 1, At, B1); PG8_BAR;
            PG8_LDA(At, 0, 1); PG8_STAGE(PG8_SA(0, 0), a2, voffA);
            PG8_BAR; PG8_WAIT_L(0); PG8_MMA(1, 0, At, B0); PG8_BAR; PG8_SCHED;
            PG8_STAGE(PG8_SB(0, 1), b2 + hstep, voffB);
            PG8_WAIT_V(6); PG8_BAR; PG8_MMA(1, 1, At, B1); PG8_BAR;
            PG8_LDB(B0, 1, 0); PG8_SCHED; PG8_LDA(At, 1, 0); PG8_STAGE(PG8_SA(0, 1), a2 + hstep, voffA);
            PG8_WAIT_L(8); PG8_BAR; PG8_WAIT_L(0); PG8_MMA(0, 0, At, B0); PG8_BAR; PG8_SCHED;
            PG8_LDB(B1, 1, 1); PG8_STAGE(PG8_SB(1, 0), b3, voffB);
            PG8_BAR; PG8_WAIT_L(0); PG8_MMA(0, 1, At, B1); PG8_BAR;
            PG8_LDA(At, 1, 1); PG8_STAGE(PG8_SA(1, 0), a3, voffA);
            PG8_BAR; PG8_WAIT_L(0); PG8_MMA(1, 0, At, B0); PG8_BAR; PG8_SCHED;
            PG8_STAGE(PG8_SB(1, 1), b3 + hstep, voffB);
            PG8_WAIT_V(6); PG8_BAR; PG8_MMA(1, 1, At, B1); PG8_BAR;
            }
        }
        if constexpr (ALIGN_EPI) { if (wr == 0) PG8_BAR; }
        if constexpr (!Epi::AFTER_DRAIN) { E(acc, cur, wr, wc, fr, fq); S.done(cur); }
        if (!has_next) break;
#pragma unroll
        for (int a = 0; a < 2; ++a)
#pragma unroll
            for (int b = 0; b < 2; ++b)
#pragma unroll
                for (int m = 0; m < 4; ++m)
#pragma unroll
                    for (int n = 0; n < 2; ++n) acc[a][b][m][n] = (f32x4){0.f, 0.f, 0.f, 0.f};
        cur = nxt; cA = nA; cB = nB; ++ui;
        if constexpr (ALIGN_EPI) { if (wr == 1) PG8_BAR; }
    }
    PG8_WAIT_V(0);
    if constexpr (!ALIGN_EPI) { if (wr == 0) PG8_BAR; }
    PG8_BAR;
    if constexpr (Epi::AFTER_DRAIN) { E.fused(acc, cur, wr, wc, fr, fq, lds, wid, lane); S.done(cur); }
#undef PG8_SA
#undef PG8_SB
#undef PG8_STAGE
#undef PG8_LDA
#undef PG8_LDB
#undef PG8_MMA
#undef PG8_WAIT_V
#undef PG8_WAIT_L
#undef PG8_BAR
#undef PG8_SCHED
}
}
constexpr int NWAVES = 8;
constexpr int BATCH = 4, SEQ = 8192, D = 1024, FF = 2816, NIN = 3584;
constexpr int M = BATCH * SEQ;
constexpr float NORM_EPS = 1e-6f;
constexpr size_t MiB = 1u << 20;
constexpr size_t WS_CTL = 0, CTL_ZERO_BYTES = 1 * MiB;
constexpr size_t WS_SS1 = 256 * 1024, WS_SS2 = 384 * 1024, WS_SS3 = 512 * 1024;
constexpr size_t WS_SS0 = 1 * MiB;
constexpr size_t WS_COS = 2 * MiB, WS_SIN = 4 * MiB;
constexpr size_t WS_WGU1 = 6 * MiB, WS_WD1 = 17 * MiB, WS_WIN = 23 * MiB, WS_WOUT = 30 * MiB, WS_WGU2 = 32 * MiB, WS_WD2 = 43 * MiB;
constexpr size_t WS_XB = 50 * MiB;
constexpr size_t WS_UA = 114 * MiB;
constexpr size_t WS_MIX = 338 * MiB;
constexpr size_t WS_ATT = 402 * MiB;
constexpr size_t WS_END = 502 * MiB;
static_assert(WS_WD2 + (size_t)D * FF * 2 <= WS_XB && WS_XB + (size_t)M * D * 2 <= WS_UA && WS_UA + (size_t)M * NIN * 2 <= WS_MIX && WS_MIX + (size_t)M * D * 2 <= WS_ATT, "d_ws map");
constexpr int CW_TMO = 0, CW_CODE = 1;
constexpr int CW_BAR = 4096;
constexpr int RING_OFF = 0, RING_BYTES = 131072;
constexpr int LDSCTL_OFF = RING_BYTES, MISC_OFF = LDSCTL_OFF + 320;
constexpr int LDS_BYTES = 147456;
constexpr int N_PHASES = 9;
#define GAS __attribute__((address_space(1)))
#define LAS __attribute__((address_space(3)))
typedef unsigned short bf16;
typedef unsigned v4u __attribute__((ext_vector_type(4)));
typedef float f32x4 __attribute__((ext_vector_type(4)));
typedef short bf16x8 __attribute__((ext_vector_type(8)));
typedef GAS unsigned gu32;
typedef GAS unsigned long long gu64;
#define RLX_AGENT __ATOMIC_RELAXED, __HIP_MEMORY_SCOPE_AGENT
#define LDS_WAIT() asm volatile("s_waitcnt lgkmcnt(0)" ::: "memory")
#define VM_WAIT() asm volatile("s_waitcnt vmcnt(0)" ::: "memory")
__device__ __forceinline__ unsigned long long rt() { return __builtin_amdgcn_s_memrealtime(); }
__device__ __forceinline__ unsigned f2bf(float f) { unsigned u = __builtin_bit_cast(unsigned, f); return (u + 0x7fffu + ((u >> 16) & 1u)) >> 16; }
__device__ __forceinline__ unsigned pk2(float lo, float hi) { return f2bf(lo) | (f2bf(hi) << 16); }

#define XB_TMO      128
#define XB_XCNT(j)  (256  + 64 * (j))
#define XB_XSUB(j)  (1280 + 64 * (j))
#define XB_XGEN(j)  (2304 + 64 * (j))
#define XB_TOP      3328
#define XB_TOPGEN   3392
#define XCD_BAR_WORDS 3456
#define XB_SPIN_CAP (1u << 18)

__device__ __forceinline__ unsigned xb_ld(unsigned* p)              { return __hip_atomic_load(p, __ATOMIC_RELAXED, __HIP_MEMORY_SCOPE_AGENT); }
__device__ __forceinline__ unsigned xb_add(unsigned* p, unsigned v) { return __hip_atomic_fetch_add(p, v, __ATOMIC_RELAXED, __HIP_MEMORY_SCOPE_AGENT); }
__device__ __forceinline__ unsigned xb_xcc_id() { return (unsigned)__builtin_amdgcn_s_getreg((3 << 11) | 20) & 0xFu; }
#define XB_SPIN(cond, bar) do { unsigned _sp = 0; while (cond) { __builtin_amdgcn_s_sleep(1); \
    if ((++_sp & 255u) == 0u) { if (xb_ld(&(bar)[XB_TMO])) break; if (_sp > XB_SPIN_CAP) { atomicAdd(&(bar)[XB_TMO], 1u); break; } } } } while (0)

struct XcdBarrier {
    unsigned* bar; unsigned x;
    volatile LAS unsigned* st;
};

__device__ __forceinline__ XcdBarrier xcd_barrier_post(unsigned* bar, volatile LAS unsigned* st) {
    XcdBarrier b; b.bar = bar; b.x = xb_xcc_id(); b.st = st;
    if (threadIdx.x == 0) (void)xb_add(&bar[XB_XCNT(b.x)], 1u);
    return b;
}
__device__ __forceinline__ void xcd_barrier_complete(unsigned* bar, unsigned x, unsigned& nloc, unsigned& nx) {
    const unsigned G = gridDim.x * gridDim.y * gridDim.z;
    unsigned sum, cnt, mine, sp = 0u;
    for (;;) {
        sum = 0u; cnt = 0u; mine = 0u;
#pragma unroll
        for (unsigned j = 0; j < 16; ++j) { const unsigned c = xb_ld(&bar[XB_XCNT(j)]); sum += c; cnt += (c > 0u) ? 1u : 0u; mine = (j == x) ? c : mine; }
        if (sum == G) break;
        __builtin_amdgcn_s_sleep(1);
        if ((++sp & 255u) == 0u) { if (xb_ld(&bar[XB_TMO])) break; if (sp > XB_SPIN_CAP) { atomicAdd(&bar[XB_TMO], 1u); break; } }
    }
    nloc = mine > 0u ? mine : 1u; nx = cnt > 0u ? cnt : 1u;
}

__device__ __forceinline__ void xcd_barrier(const XcdBarrier& b) {
    asm volatile("s_waitcnt vmcnt(0)" ::: "memory");
    __syncthreads();
    if (threadIdx.x == 0) {
        unsigned* bar = b.bar;
        __builtin_amdgcn_s_waitcnt(0);
        unsigned nloc = b.st[0], nx = b.st[1];
        if (nloc == 0u) { xcd_barrier_complete(bar, b.x, nloc, nx); b.st[0] = nloc; b.st[1] = nx; }
        const unsigned old = xb_add(&bar[XB_XSUB(b.x)], 1u);
        const unsigned gen = old / nloc;
        if (old + 1u == (gen + 1u) * nloc) {
            __builtin_amdgcn_fence(__ATOMIC_RELEASE, "agent");
            asm volatile("s_waitcnt vmcnt(0)" ::: "memory");
            const unsigned og = xb_add(&bar[XB_TOP], 1u);
            const unsigned tg = og / nx;
            if (og + 1u == (tg + 1u) * nx) xb_add(&bar[XB_TOPGEN], 1u);
            else XB_SPIN(xb_ld(&bar[XB_TOPGEN]) == tg, bar);
            __builtin_amdgcn_fence(__ATOMIC_ACQUIRE, "agent");
            xb_add(&bar[XB_XGEN(b.x)], 1u);
            asm volatile("s_waitcnt vmcnt(0)" ::: "memory");
        } else {
            XB_SPIN(xb_ld(&bar[XB_XGEN(b.x)]) == gen, bar);
            __builtin_amdgcn_fence(__ATOMIC_ACQUIRE, "agent");
            asm volatile("s_waitcnt vmcnt(0)" ::: "memory");
        }
    }
    __syncthreads();
}
struct Frame {
    LAS unsigned char* lds;
    volatile LAS unsigned* MISC;
    gu32* ctl;
    int tid, lane, wave;
    int vcu, G;
};
__device__ __forceinline__ float wave_sum(float v) {
#pragma unroll
    for (int o = 1; o < 64; o <<= 1) v += __shfl_xor(v, o);
    return v;
}
__device__ __forceinline__ float bf2f(unsigned short b) { return __uint_as_float((unsigned)b << 16); }

__device__ __forceinline__ void p0_transpose_item(const float* W, int K, int N, bf16* WT, const float* gain, int mode, LAS float* scr, int item, int lane) {
    const int nblk = N / 32, kb = item / nblk, nb = item % nblk, k0 = 64 * kb, n0 = 32 * nb;
#pragma unroll 8
    for (int i = 0; i < 32; ++i) { const int kk = 2 * i + (lane >> 5); float w = W[(size_t)(k0 + kk) * N + n0 + (lane & 31)]; if (gain) w *= gain[k0 + kk]; scr[kk * 33 + (lane & 31)] = w; }
    LDS_WAIT(); asm volatile("" ::: "memory");
    const int c = lane & 7;
    const int drow0 = (mode == 0) ? n0 : ((n0 >> 7) * 256 + (n0 & 127) + (mode == 2 ? 128 : 0));
#pragma unroll
    for (int j = 0; j < 4; ++j) { const int n = (lane >> 3) + 8 * j; const LAS float* s = scr + (8 * c) * 33 + n;
        v4u o; o.x = pk2(s[0 * 33], s[1 * 33]); o.y = pk2(s[2 * 33], s[3 * 33]); o.z = pk2(s[4 * 33], s[5 * 33]); o.w = pk2(s[6 * 33], s[7 * 33]);
        *(GAS v4u*)(WT + (size_t)(drow0 + n) * K + k0 + 8 * c) = o; }
    LDS_WAIT(); asm volatile("" ::: "memory");
}

struct Args { const float* in[14]; float* out; unsigned char* ws; int ph_lo, ph_hi, li, pad; };

__device__ __forceinline__ void p0_prologue(Frame& F, const Args& args) {
    unsigned char* ws = args.ws;
    LAS float* scr = (LAS float*)(F.lds + RING_OFF + F.wave * 16384);
    const int gw = F.vcu * NWAVES + F.wave, NGW = F.G * NWAVES;
    constexpr int I_GU = (D / 64) * (FF / 32), I_DN = (FF / 64) * (D / 32), I_IN = (D / 64) * (NIN / 32), I_OUT = (D / 64) * (D / 32);
    constexpr int NITEMS = 4 * I_GU + 2 * I_DN + I_IN + I_OUT;
    for (int it = gw; it < NITEMS; it += NGW) {
        int r = it;
        if (r < I_GU) { p0_transpose_item(args.in[2], D, FF, (bf16*)(ws + WS_WGU1), args.in[1], 1, scr, r, F.lane); continue; } r -= I_GU;
        if (r < I_GU) { p0_transpose_item(args.in[3], D, FF, (bf16*)(ws + WS_WGU1), args.in[1], 2, scr, r, F.lane); continue; } r -= I_GU;
        if (r < I_DN) { p0_transpose_item(args.in[4], FF, D, (bf16*)(ws + WS_WD1), nullptr, 0, scr, r, F.lane); continue; } r -= I_DN;
        if (r < I_IN) { p0_transpose_item(args.in[6], D, NIN, (bf16*)(ws + WS_WIN), args.in[5], 0, scr, r, F.lane); continue; } r -= I_IN;
        if (r < I_OUT) { p0_transpose_item(args.in[8], D, D, (bf16*)(ws + WS_WOUT), nullptr, 0, scr, r, F.lane); continue; } r -= I_OUT;
        if (r < I_GU) { p0_transpose_item(args.in[10], D, FF, (bf16*)(ws + WS_WGU2), args.in[9], 1, scr, r, F.lane); continue; } r -= I_GU;
        if (r < I_GU) { p0_transpose_item(args.in[11], D, FF, (bf16*)(ws + WS_WGU2), args.in[9], 2, scr, r, F.lane); continue; } r -= I_GU;
        p0_transpose_item(args.in[12], FF, D, (bf16*)(ws + WS_WD2), nullptr, 0, scr, r, F.lane);
    }
    {
        const float* x = args.in[0]; bf16* xb = (bf16*)(ws + WS_XB); float* ss0 = (float*)(ws + WS_SS0);
        for (int m = gw; m < M; m += NGW) {
            const GAS f32x4* xr = (const GAS f32x4*)(x + (size_t)m * D) + F.lane;
            f32x4 v[4]; float s = 0.f;
#pragma unroll
            for (int j = 0; j < 4; ++j) { v[j] = xr[64 * j]; s += (v[j].x * v[j].x + v[j].y * v[j].y) + (v[j].z * v[j].z + v[j].w * v[j].w); }
            s = wave_sum(s);
            GAS unsigned long long* o8 = (GAS unsigned long long*)(xb + (size_t)m * D) + F.lane;
#pragma unroll
            for (int j = 0; j < 4; ++j) o8[64 * j] = (unsigned long long)pk2(v[j].x, v[j].y) | ((unsigned long long)pk2(v[j].z, v[j].w) << 32);
            if (F.lane == 0) ss0[m] = s;
        }
    }
    {
        float* cosT = (float*)(ws + WS_COS); float* sinT = (float*)(ws + WS_SIN);
        const int gt = F.vcu * (NWAVES * 64) + F.tid, NGT = F.G * NWAVES * 64;
        for (int e = gt; e < SEQ * 64; e += NGT) {
            const int s = e >> 6, i = e & 63;
            const float inv = powf(10000.0f, -(float)(2 * i) / 128.0f);
            const float ang = (float)s * inv;
            cosT[e] = cosf(ang); sinT[e] = sinf(ang);
        }
    }
}

__device__ __forceinline__ void p8_final(Frame& F, const Args& args) {
    const int gw = F.vcu * NWAVES + F.wave, NGW = F.G * NWAVES;
    const float* ss3 = (const float*)(args.ws + WS_SS3); const float* g = args.in[13];
    f32x4 gv[4];
#pragma unroll
    for (int j = 0; j < 4; ++j) gv[j] = ((const GAS f32x4*)g)[F.lane + 64 * j];
    for (int m = gw; m < M; m += NGW) {
        GAS f32x4* xr = (GAS f32x4*)(args.out + (size_t)m * D) + F.lane;
        const float rs = 1.0f / sqrtf(ss3[m] * (1.0f / 1024.0f) + NORM_EPS);
#pragma unroll
        for (int j = 0; j < 4; ++j) { f32x4 v = xr[64 * j]; v = v * rs * gv[j]; xr[64 * j] = v; }
    }
}

__global__ void __launch_bounds__(NWAVES * 64, 2) mk_fwd(Args args) {
    extern __shared__ __attribute__((aligned(16))) unsigned char lds[];
    Frame F;
    F.lds = (LAS unsigned char*)lds;
    F.MISC = (volatile LAS unsigned*)(F.lds + MISC_OFF);
    F.tid = threadIdx.x; F.lane = F.tid & 63; F.wave = __builtin_amdgcn_readfirstlane(F.tid >> 6);
    F.G = gridDim.x; { const int bx = blockIdx.x; F.vcu = (F.G % 8 == 0) ? (bx % 8) * (F.G / 8) + bx / 8 : bx; }
    unsigned char* ws = args.ws;
    F.ctl = (gu32*)(ws + WS_CTL);
    for (int u = F.tid; u < (LDS_BYTES - LDSCTL_OFF) / 4; u += NWAVES * 64) ((LAS unsigned*)(F.lds + LDSCTL_OFF))[u] = 0u;
    __syncthreads();
    XcdBarrier bar = xcd_barrier_post((unsigned*)(F.ctl + CW_BAR) + args.li * XCD_BAR_WORDS, F.MISC + 8);
#define GRID_BAR() xcd_barrier(bar)
    const int lo = args.ph_lo, hi = args.ph_hi;
#define IN(k) (lo <= (k) && (k) < hi)
#define BOTH(k) (IN(k) && IN((k) + 1))
    bf16* XB = (bf16*)(ws + WS_XB); bf16* UA = (bf16*)(ws + WS_UA); bf16* MIX = (bf16*)(ws + WS_MIX);
    float* SS0 = (float*)(ws + WS_SS0); float* SS1 = (float*)(ws + WS_SS1); float* SS2 = (float*)(ws + WS_SS2); float* SS3 = (float*)(ws + WS_SS3);

    if (IN(0)) { p0_prologue(F, args); if (BOTH(0)) GRID_BAR(); }
    if (IN(1)) {
        pg8::Gemm g{XB, (const bf16*)(ws + WS_WGU1), M, 2 * FF, D}; pg8::StaticOrder S; S.init(M, 2 * FF, F.G, (int)blockIdx.x);
        pg8::EpiSwiGLU E{UA, FF, SS0};
        pg8::gemm_phase<pg8::EpiSwiGLU, pg8::StaticOrder, true, true>(F.lds + RING_OFF, g, S, E);
        if (BOTH(1)) GRID_BAR();
    }
    if (IN(2)) {
        pg8::Gemm g{UA, (const bf16*)(ws + WS_WD1), M, D, FF}; pg8::StaticOrder S; S.init(M, D, F.G, (int)blockIdx.x);
        pg8::EpiResid<true> E{args.in[0], args.out, XB, 0.5f, SS1};
        pg8::gemm_phase<pg8::EpiResid<true>, pg8::StaticOrder, true, true>(F.lds + RING_OFF, g, S, E);
        if (BOTH(2)) GRID_BAR();
    }
    if (IN(3)) {
        pg8::Gemm g{XB, (const bf16*)(ws + WS_WIN), M, NIN, D}; pg8::StaticOrder S; S.init(M, NIN, F.G, (int)blockIdx.x);
        pg8::EpiUProj E{UA, SS1, (const float*)(ws + WS_COS), (const float*)(ws + WS_SIN)};
        pg8::gemm_phase<pg8::EpiUProj, pg8::StaticOrder, true, true>(F.lds + RING_OFF, g, S, E);
        if (BOTH(3)) GRID_BAR();
    }
    if (IN(4)) {
        if (BOTH(4)) GRID_BAR();
    }
    if (IN(5)) {
        pg8::Gemm g{MIX, (const bf16*)(ws + WS_WOUT), M, D, D}; pg8::StaticOrder S; S.init(M, D, F.G, (int)blockIdx.x);
        pg8::EpiResid<true> E{args.out, args.out, XB, 1.0f, SS2};
        pg8::gemm_phase<pg8::EpiResid<true>, pg8::StaticOrder, true, true>(F.lds + RING_OFF, g, S, E);
        if (BOTH(5)) GRID_BAR();
    }
    if (IN(6)) {
        pg8::Gemm g{XB, (const bf16*)(ws + WS_WGU2), M, 2 * FF, D}; pg8::StaticOrder S; S.init(M, 2 * FF, F.G, (int)blockIdx.x);
        pg8::EpiSwiGLU E{UA, FF, SS2};
        pg8::gemm_phase<pg8::EpiSwiGLU, pg8::StaticOrder, true, true>(F.lds + RING_OFF, g, S, E);
        if (BOTH(6)) GRID_BAR();
    }
    if (IN(7)) {
        pg8::Gemm g{UA, (const bf16*)(ws + WS_WD2), M, D, FF}; pg8::StaticOrder S; S.init(M, D, F.G, (int)blockIdx.x);
        pg8::EpiResid<false> E{args.out, args.out, nullptr, 0.5f, SS3};
        pg8::gemm_phase<pg8::EpiResid<false>, pg8::StaticOrder, true, true>(F.lds + RING_OFF, g, S, E);
        if (BOTH(7)) GRID_BAR();
    }
    if (IN(8)) { p8_final(F, args); }
#undef IN
#undef BOTH
}

__global__ __launch_bounds__(1024) void ret_recur(const bf16* u, float* ret) {
    const int b = blockIdx.x >> 2, h = blockIdx.x & 3, e = threadIdx.x & 127, dg = threadIdx.x >> 7;
    const float gamma = 1.0f - exp2f(-5.0f - (float)h);
    float st[16];
#pragma unroll
    for (int i = 0; i < 16; ++i) st[i] = 0.f;
    __shared__ float part[2][8][128];
    for (int t = 0; t < SEQ; ++t) {
        const bf16* row = u + (size_t)(b * SEQ + t) * NIN;
        const float v = bf2f(row[1024 + h * 128 + e]);
        float o = 0.f;
#pragma unroll
        for (int i = 0; i < 16; ++i) { const float k = bf2f(row[512 + h * 128 + 16 * dg + i]), q = bf2f(row[h * 128 + 16 * dg + i]); st[i] = gamma * st[i] + k * v; o += q * st[i]; }
        part[t & 1][dg][e] = o;
        __syncthreads();
        if (dg == 0) { float s = 0.f;
#pragma unroll
            for (int g = 0; g < 8; ++g) s += part[t & 1][g][e];
            ret[(size_t)(b * SEQ + t) * 512 + h * 128 + e] = s; }
    }
}
__global__ __launch_bounds__(256) void gn_gate_k(const float* ret, const bf16* u, const float* gain, bf16* mix) {
    const int w = blockIdx.x * 4 + (threadIdx.x >> 6), lane = threadIdx.x & 63;
    const int t = w >> 2, h = w & 3;
    if (t >= M) return;
    const float a = ret[(size_t)t * 512 + h * 128 + lane], b = ret[(size_t)t * 512 + h * 128 + 64 + lane];
    const float mu = wave_sum(a + b) * (1.0f / 128.0f);
    const float da = a - mu, db = b - mu;
    const float var = wave_sum(da * da + db * db) * (1.0f / 128.0f);
    const float r = 1.0f / sqrtf(var + 1e-6f);
    const float g0 = bf2f(u[(size_t)t * NIN + 1536 + h * 128 + lane]), g1 = bf2f(u[(size_t)t * NIN + 1536 + h * 128 + 64 + lane]);
    mix[(size_t)t * D + h * 128 + lane] = (bf16)f2bf(da * r * gain[h * 128 + lane] * (g0 / (1.0f + expf(-g0))));
    mix[(size_t)t * D + h * 128 + 64 + lane] = (bf16)f2bf(db * r * gain[h * 128 + 64 + lane] * (g1 / (1.0f + expf(-g1))));
}
__global__ __launch_bounds__(256) void attn_naive(const bf16* u, bf16* mix) {
    const int w = blockIdx.x * 4 + (threadIdx.x >> 6), lane = threadIdx.x & 63;
    const int tg = w >> 3, h = w & 7;
    if (tg >= M) return;
    const int t = tg & (SEQ - 1); const bf16* ub = u + (size_t)(tg - t) * NIN;
    const float q = bf2f(ub[(size_t)t * NIN + 2048 + h * 64 + lane]);
    float lse[3], op[3];
#pragma unroll
    for (int p = 0; p < 3; ++p) {
        const int dil = (p == 0) ? 1 : (p == 1) ? 4 : 16;
        float m = -INFINITY, l = 0.f, o = 0.f;
        for (int dist = 0; dist <= 128; ++dist) {
            const int tk = t - dil * dist;
            if (tk < 0) break;
            const float k = bf2f(ub[(size_t)tk * NIN + 2560 + h * 64 + lane]);
            const float v = bf2f(ub[(size_t)tk * NIN + 3072 + h * 64 + lane]);
            const float s = wave_sum(q * k);
            const float mn = fmaxf(m, s);
            const float a = expf(m - mn), pe = expf(s - mn);
            l = l * a + pe; o = o * a + pe * v; m = mn;
        }
        lse[p] = m + logf(l); op[p] = o / l;
    }
    const float Mx = fmaxf(lse[0], fmaxf(lse[1], lse[2]));
    const float w0 = expf(lse[0] - Mx), w1 = expf(lse[1] - Mx), w2 = expf(lse[2] - Mx);
    mix[(size_t)tg * D + 512 + h * 64 + lane] = (bf16)f2bf((w0 * op[0] + w1 * op[1] + w2 * op[2]) / (w0 + w1 + w2));
}

extern "C" void kernel_launch(void* const* d_in, const int* in_sizes, int n_in, void* d_out, int out_size, void* d_ws, size_t ws_size, hipStream_t stream) {
    static int grid = 0;
    if (grid == 0) {
        if (n_in != 14 || in_sizes[0] != M * D || out_size != M * D || ws_size < WS_END) { fprintf(stderr, "kernel_launch: unexpected shapes (n_in %d, in0 %d, out %d, ws %zu)\n", n_in, n_in > 0 ? in_sizes[0] : -1, out_size, ws_size); grid = -1; return; }
        int dev = 0, cus = 0;
        if (hipGetDevice(&dev) != hipSuccess || hipDeviceGetAttribute(&cus, hipDeviceAttributeMultiprocessorCount, dev) != hipSuccess) { grid = -1; return; }
        if (hipFuncSetAttribute((const void*)mk_fwd, hipFuncAttributeMaxDynamicSharedMemorySize, LDS_BYTES) != hipSuccess) { fprintf(stderr, "kernel_launch: hipFuncSetAttribute failed\n"); grid = -1; return; }
        int per_cu = 0;
        if (hipOccupancyMaxActiveBlocksPerMultiprocessor(&per_cu, (const void*)mk_fwd, NWAVES * 64, LDS_BYTES) != hipSuccess || per_cu < 1) fprintf(stderr, "kernel_launch: occupancy query says %d\n", per_cu);
        (void)hipGetLastError();
        grid = cus;
    }
    if (grid < 0) return;
    (void)hipMemsetAsync((char*)d_ws + WS_CTL, 0, CTL_ZERO_BYTES, stream);
    Args a{};
    for (int i = 0; i < 14; ++i) a.in[i] = (const float*)d_in[i];
    a.out = (float*)d_out; a.ws = (unsigned char*)d_ws;
    unsigned char* ws = (unsigned char*)d_ws;
    a.ph_lo = 0; a.ph_hi = 4; a.li = 0;
    hipLaunchKernelGGL(mk_fwd, dim3(grid), dim3(NWAVES * 64), LDS_BYTES, stream, a);
    ret_recur<<<16, 1024, 0, stream>>>((const bf16*)(ws + WS_UA), (float*)(ws + WS_ATT));
    gn_gate_k<<<M, 256, 0, stream>>>((const float*)(ws + WS_ATT), (const bf16*)(ws + WS_UA), (const float*)d_in[7], (bf16*)(ws + WS_MIX));
    attn_naive<<<M * 2, 256, 0, stream>>>((const bf16*)(ws + WS_UA), (bf16*)(ws + WS_MIX));
    a.ph_lo = 5; a.ph_hi = 9; a.li = 1;
    hipLaunchKernelGGL(mk_fwd, dim3(grid), dim3(NWAVES * 64), LDS_BYTES, stream, a);
}
```

```cpp
#include <hip/hip_runtime.h>
#include <cstdio>
#include <cstdint>
#include <cmath>
namespace pg8 {
#define PG8_LAS __attribute__((address_space(3)))
typedef unsigned short bf16_t;
typedef short bf16x8 __attribute__((ext_vector_type(8)));
typedef float f32x4 __attribute__((ext_vector_type(4)));
typedef unsigned u32x4 __attribute__((ext_vector_type(4)));
constexpr int BM = 256, BK = 64, HALF = 128, HTB = HALF * BK * 2  , STAGE_BYTES = 8 * HTB, NXCD = 8, WGM = 8;

__host__ __device__ __forceinline__ int lds_byte(int r, int c) { const int st = (r >> 4) * 2 + (c >> 5), rr = r & 15, cc = c & 31, ob = rr * 64 + cc * 2; return st * 1024 + (ob ^ (((ob >> 9) & 1) << 5)); }
__host__ __device__ __forceinline__ void stage_rc(int b, int& R, int& C) { const int st = b / 1024, sb = b % 1024, swz = sb ^ (((sb >> 9) & 1) << 5); R = (st >> 1) * 16 + swz / 64; C = (st & 1) * 32 + (swz % 64) / 2; }
__host__ __device__ __forceinline__ int perm32(int rho) { const int n = rho >> 4, i = rho & 15; return 8 * (i >> 2) + 4 * n + (i & 3); }

struct Unit { int pm, pn; };
struct Gemm { const bf16_t* A; const bf16_t* Bt; int M, N, K; };

struct StaticOrder {
    int nM, nN, nwg, G, c;
    __host__ __device__ void init(int M, int N, int G_, int c_) { nM = M / BM; nN = N / BM; nwg = nM * nN; G = G_; c = c_; }
    __host__ __device__ bool next(int i, Unit& u) const {
        const long L = (long)i * G + c; if (L >= nwg) return false;
        int wgid = (int)L; { const int q = nwg / NXCD, r = nwg % NXCD, xcd = wgid % NXCD, off = wgid / NXCD; wgid = (xcd < r ? xcd * (q + 1) : r * (q + 1) + (xcd - r) * q) + off; }
        const int nig = WGM * nN, gid = wgid / nig, fm = gid * WGM, gsz = (nM - fm) < WGM ? (nM - fm) : WGM;
        u.pm = fm + ((wgid % nig) % gsz); u.pn = (wgid % nig) / gsz; return true;
    }
    __device__ __forceinline__ void a_ready(const Unit&) const {}
    __device__ __forceinline__ void done(const Unit&) const {}
};

__device__ __forceinline__ unsigned cvt_pk_bf16(float lo, float hi) { unsigned r; asm volatile("v_cvt_pk_bf16_f32 %0, %1, %2" : "=v"(r) : "v"(lo), "v"(hi)); return r; }
typedef float f32x2 __attribute__((ext_vector_type(2)));
typedef float f32x2_t __attribute__((ext_vector_type(2))); typedef __bf16 bf16x2_t __attribute__((ext_vector_type(2)));
__device__ __forceinline__ unsigned cvtpk_m(float lo, float hi) { f32x2_t v = {lo, hi}; bf16x2_t b = __builtin_convertvector(v, bf16x2_t); return __builtin_bit_cast(unsigned, b); }
__device__ __forceinline__ float fast_rcp(float x) { return __builtin_amdgcn_rcpf(x); }
__device__ __forceinline__ float silu_fast(float v) { return v * fast_rcp(1.0f + __builtin_amdgcn_exp2f(-1.4426950408889634f * v)); }
__device__ __forceinline__ float row_rs(const float* ss, int row) { return 1.0f / sqrtf(ss[row] * (1.0f / 1024.0f) + 1e-6f); }

struct EpiSwiGLU {
    static constexpr bool PERM = true, AFTER_DRAIN = false;
    bf16_t* O; int ldc; const float* ss;
    __device__ __forceinline__ void operator()(const f32x4 (&acc)[2][2][4][2], const Unit& u, int wr, int wc, int fr, int fq) const {
        const int row0 = u.pm * BM + wr * 64 + fr, col0 = u.pn * HALF + wc * 32 + 8 * fq;
#pragma unroll
        for (int ai = 0; ai < 2; ++ai)
#pragma unroll
            for (int m = 0; m < 4; ++m) {
                const int row = row0 + ai * HALF + m * 16; const float rs = row_rs(ss, row);
                const f32x4 g0 = acc[ai][0][m][0] * rs, g1 = acc[ai][0][m][1] * rs, u0 = acc[ai][1][m][0] * rs, u1 = acc[ai][1][m][1] * rs;
                u32x4 w;
                w.x = cvtpk_m(silu_fast(g0[0]) * u0[0], silu_fast(g0[1]) * u0[1]); w.y = cvtpk_m(silu_fast(g0[2]) * u0[2], silu_fast(g0[3]) * u0[3]);
                w.z = cvtpk_m(silu_fast(g1[0]) * u1[0], silu_fast(g1[1]) * u1[1]); w.w = cvtpk_m(silu_fast(g1[2]) * u1[2], silu_fast(g1[3]) * u1[3]);
                *(u32x4*)(O + (size_t)row * ldc + col0) = w;
            }
    }
};

template <bool WITH_BF16> struct EpiResid {
    static constexpr bool PERM = false, AFTER_DRAIN = false;
    const float* base; float* out; bf16_t* ob; float alpha; float* ss;
    __device__ __forceinline__ void operator()(const f32x4 (&acc)[2][2][4][2], const Unit& u, int wr, int wc, int fr, int fq) const {
        typedef unsigned u32x2v __attribute__((ext_vector_type(2)));
        const int row0 = u.pm * BM + wr * 64 + fr, col0 = u.pn * BM + wc * 32 + 4 * fq;
#pragma unroll
        for (int ai = 0; ai < 2; ++ai)
#pragma unroll
            for (int m = 0; m < 4; ++m) {
                const int row = row0 + ai * HALF + m * 16; const size_t off = (size_t)row * 1024 + col0; float sq = 0.f;
#pragma unroll
                for (int bj = 0; bj < 2; ++bj)
#pragma unroll
                    for (int n = 0; n < 2; ++n) {
                        const f32x4 b = *(const f32x4*)(base + off + bj * HALF + n * 16);
                        const f32x4 o = b + acc[ai][bj][m][n] * alpha;
                        *(f32x4*)(out + off + bj * HALF + n * 16) = o;
                        sq += (o[0] * o[0] + o[1] * o[1]) + (o[2] * o[2] + o[3] * o[3]);
                        if (WITH_BF16) { u32x2v w; w.x = cvtpk_m(o[0], o[1]); w.y = cvtpk_m(o[2], o[3]); *(u32x2v*)(ob + off + bj * HALF + n * 16) = w; }
                    }
                sq += __shfl_xor(sq, 16); sq += __shfl_xor(sq, 32);
                if (fq == 0) (void)__hip_atomic_fetch_add(ss + row, sq, __ATOMIC_RELAXED, __HIP_MEMORY_SCOPE_AGENT);
                asm volatile("" ::: "memory");
            }
    }
};

struct EpiUProj {
    static constexpr bool PERM = true, AFTER_DRAIN = false;
    bf16_t* U; const float* ss; const float* cosT; const float* sinT;
    __device__ __forceinline__ void operator()(const f32x4 (&acc)[2][2][4][2], const Unit& u, int wr, int wc, int fr, int fq) const {
        const int row0 = u.pm * BM + wr * 64 + fr, col0 = u.pn * BM + wc * 32 + 8 * fq;
        const bool rot = u.pn < 4;
        const float sc = (u.pn == 2 || u.pn == 3) ? 0.08838834764831845f : ((u.pn == 8 || u.pn == 9) ? 0.125f : 1.0f);
#pragma unroll
        for (int ai = 0; ai < 2; ++ai)
#pragma unroll
            for (int m = 0; m < 4; ++m) {
                const int row = row0 + ai * HALF + m * 16; const float rs = row_rs(ss, row) * sc;
                f32x4 c4 = (f32x4){1.f, 1.f, 1.f, 1.f}, s4 = (f32x4){0.f, 0.f, 0.f, 0.f};
                if (rot) { const int pos = row & 8191; c4 = *(const f32x4*)(cosT + pos * 64 + 16 * wc + 4 * fq); s4 = *(const f32x4*)(sinT + pos * 64 + 16 * wc + 4 * fq); }
#pragma unroll
                for (int bj = 0; bj < 2; ++bj) {
                    const f32x4 v0 = acc[ai][bj][m][0] * rs, v1 = acc[ai][bj][m][1] * rs;
                    u32x4 w;
                    w.x = cvtpk_m(v0[0] * c4[0] - v0[1] * s4[0], v0[1] * c4[0] + v0[0] * s4[0]);
                    w.y = cvtpk_m(v0[2] * c4[1] - v0[3] * s4[1], v0[3] * c4[1] + v0[2] * s4[1]);
                    w.z = cvtpk_m(v1[0] * c4[2] - v1[1] * s4[2], v1[1] * c4[2] + v1[0] * s4[2]);
                    w.w = cvtpk_m(v1[2] * c4[3] - v1[3] * s4[3], v1[3] * c4[3] + v1[2] * s4[3]);
                    *(u32x4*)(U + (size_t)row * 3584 + col0 + bj * HALF) = w;
                }
            }
    }
};
template <class Epi, class Sched, bool ALIGN_EPI = false, bool SP2 = false>
__device__ __forceinline__ void gemm_phase(PG8_LAS unsigned char* lds, const Gemm g, const Sched& S, const Epi& E) {
    const int tid = threadIdx.x, wid = __builtin_amdgcn_readfirstlane(tid >> 6), lane = tid & 63, wr = wid >> 2, wc = wid & 3, fr = lane & 15, fq = lane >> 4;
    const int K = g.K, nt = K / BK;
    unsigned voffA[2], voffB[2];
#pragma unroll
    for (int i = 0; i < 2; ++i) { int R, C; stage_rc(tid * 16 + i * 8192, R, C); const int Rb = Epi::PERM ? ((R & ~31) + perm32(R & 31)) : R;
        voffA[i] = (unsigned)(R * K + C) * 2u; voffB[i] = (unsigned)(Rb * K + C) * 2u; }
    const size_t kstep = (size_t)(BK * 2);
    const size_t hstep = (size_t)HALF * K * 2;
    const size_t tstep = 2 * hstep;
    const unsigned ldsw = (unsigned)wid * 1024u;
    const int aoff = lds_byte(wr * 64 + fr, fq * 8), boff = lds_byte(wc * 32 + fr, fq * 8);
#define PG8_SA(b, h) (((b) * 2 + (h)) * HTB)
#define PG8_SB(b, h) ((4 + (b) * 2 + (h)) * HTB)
#define PG8_STAGE(bufoff, gbase, voff) do { _Pragma("unroll") for (int _i = 0; _i < 2; ++_i) \
        __builtin_amdgcn_global_load_lds((const unsigned*)((const char*)(gbase) + (voff)[_i]), (PG8_LAS unsigned*)(lds + (bufoff) + ldsw + _i * 8192), 16, 0, 0); } while (0)
#define PG8_LDA(dst, b, h) do { _Pragma("unroll") for (int m = 0; m < 4; ++m) _Pragma("unroll") for (int k = 0; k < 2; ++k) dst[m][k] = *(const PG8_LAS bf16x8*)(lds + PG8_SA(b, h) + aoff + m * 2048 + k * 1024); } while (0)
#define PG8_LDB(dst, b, h) do { _Pragma("unroll") for (int n = 0; n < 2; ++n) _Pragma("unroll") for (int k = 0; k < 2; ++k) dst[n][k] = *(const PG8_LAS bf16x8*)(lds + PG8_SB(b, h) + boff + n * 2048 + k * 1024); } while (0)
#define PG8_MMA(ai, bj, At, Bt) do { __builtin_amdgcn_s_setprio(1); _Pragma("unroll") for (int m = 0; m < 4; ++m) _Pragma("unroll") for (int n = 0; n < 2; ++n) _Pragma("unroll") for (int k = 0; k < 2; ++k) \
        acc[ai][bj][m][n] = __builtin_amdgcn_mfma_f32_16x16x32_bf16(Bt[n][k], At[m][k], acc[ai][bj][m][n], 0, 0, 0); __builtin_amdgcn_s_setprio(0); } while (0)
#define PG8_WAIT_V(n) asm volatile("s_waitcnt vmcnt(" #n ")" ::: "memory")
#define PG8_WAIT_L(n) asm volatile("s_waitcnt lgkmcnt(" #n ")" ::: "memory")
#define PG8_BAR __builtin_amdgcn_s_barrier()
#define PG8_SCHED __builtin_amdgcn_sched_barrier(0)
    Unit cur, nxt; int ui = 0;
    if (!S.next(0, cur)) return;
    f32x4 acc[2][2][4][2];
#pragma unroll
    for (int a = 0; a < 2; ++a)
#pragma unroll
        for (int b = 0; b < 2; ++b)
#pragma unroll
            for (int m = 0; m < 4; ++m)
#pragma unroll
                for (int n = 0; n < 2; ++n) acc[a][b][m][n] = (f32x4){0.f, 0.f, 0.f, 0.f};
    bf16x8 At[4][2], B0[2][2], B1[2][2];
    const char* cA = (const char*)g.A + (size_t)cur.pm * tstep; const char* cB = (const char*)g.Bt + (size_t)cur.pn * tstep;
    S.a_ready(cur);
    if constexpr (SP2) {
        PG8_STAGE(PG8_SB(0, 0), cB, voffB); PG8_STAGE(PG8_SB(0, 1), cB + hstep, voffB); PG8_STAGE(PG8_SA(0, 0), cA, voffA); PG8_STAGE(PG8_SA(0, 1), cA + hstep, voffA);
        if (wr == 1) PG8_BAR;
        PG8_WAIT_V(2); PG8_BAR;
        PG8_STAGE(PG8_SB(1, 0), cB + kstep, voffB); PG8_STAGE(PG8_SA(1, 0), cA + kstep, voffA); PG8_STAGE(PG8_SB(1, 1), cB + hstep + kstep, voffB);
        PG8_WAIT_V(6); PG8_BAR;
    } else {
        PG8_STAGE(PG8_SB(0, 0), cB, voffB); PG8_STAGE(PG8_SA(0, 0), cA, voffA); PG8_STAGE(PG8_SB(0, 1), cB + hstep, voffB); PG8_STAGE(PG8_SA(0, 1), cA + hstep, voffA);
        if (wr == 1) PG8_BAR;
        PG8_WAIT_V(4); PG8_BAR;
        PG8_STAGE(PG8_SB(1, 0), cB + kstep, voffB); PG8_STAGE(PG8_SA(1, 0), cA + kstep, voffA); PG8_STAGE(PG8_SB(1, 1), cB + hstep + kstep, voffB);
        PG8_WAIT_V(6); PG8_BAR;
    }
    for (;;) {
        const bool has_next = S.next(ui + 1, nxt);
        const char* nA = has_next ? (const char*)g.A + (size_t)nxt.pm * tstep : cA; const char* nB = has_next ? (const char*)g.Bt + (size_t)nxt.pn * tstep : cB;
        for (int t = 0; t < nt; t += 2) {
            const bool last = (t == nt - 2);
            const char* a1 = cA + (size_t)(t + 1) * kstep;
            const char* a2 = last ? nA : cA + (size_t)(t + 2) * kstep; const char* b2 = last ? nB : cB + (size_t)(t + 2) * kstep;
            const char* a3 = a2 + kstep; const char* b3 = b2 + kstep;
            if (last && has_next) S.a_ready(nxt);
            if constexpr (SP2) {
            PG8_LDB(B0, 0, 0); PG8_LDB(B1, 0, 1); PG8_SCHED; PG8_LDA(At, 0, 0); PG8_STAGE(PG8_SA(1, 1), a1 + hstep, voffA);
            PG8_WAIT_V(8); PG8_WAIT_L(0); PG8_BAR; PG8_MMA(0, 0, At, B0); PG8_MMA(0, 1, At, B1); PG8_BAR; PG8_SCHED;
            PG8_LDA(At, 0, 1); PG8_STAGE(PG8_SB(0, 0), b2, voffB); PG8_STAGE(PG8_SB(0, 1), b2 + hstep, voffB); PG8_STAGE(PG8_SA(0, 0), a2, voffA);
            PG8_WAIT_V(8); PG8_WAIT_L(0); PG8_BAR; PG8_MMA(1, 0, At, B0); PG8_MMA(1, 1, At, B1); PG8_BAR; PG8_SCHED;
            PG8_LDB(B0, 1, 0); PG8_LDB(B1, 1, 1); PG8_SCHED; PG8_LDA(At, 1, 0); PG8_STAGE(PG8_SA(0, 1), a2 + hstep, voffA);
            PG8_WAIT_V(8); PG8_WAIT_L(0); PG8_BAR; PG8_MMA(0, 0, At, B0); PG8_MMA(0, 1, At, B1); PG8_BAR; PG8_SCHED;
            PG8_LDA(At, 1, 1); PG8_STAGE(PG8_SB(1, 0), b3, voffB); PG8_STAGE(PG8_SB(1, 1), b3 + hstep, voffB); PG8_STAGE(PG8_SA(1, 0), a3, voffA);
            PG8_WAIT_V(8); PG8_WAIT_L(0); PG8_BAR; PG8_MMA(1, 0, At, B0); PG8_MMA(1, 1, At, B1); PG8_BAR; PG8_SCHED;
            } else {
            PG8_LDB(B0, 0, 0); PG8_SCHED; PG8_LDA(At, 0, 0); PG8_STAGE(PG8_SA(1, 1), a1 + hstep, voffA);
            PG8_WAIT_L(8); PG8_BAR; PG8_WAIT_L(0); PG8_MMA(0, 0, At, B0); PG8_BAR; PG8_SCHED;
            PG8_LDB(B1, 0, 1); PG8_STAGE(PG8_SB(0, 0), b2, voffB);
            PG8_BAR; PG8_WAIT_L(0); PG8_MMA(0, 1, At, B1); PG8_BAR;
            PG8_LDA(At, 0, 1); PG8_STAGE(PG8_SA(0, 0), a2, voffA);
            PG8_BAR; PG8_WAIT_L(0); PG8_MMA(1, 0, At, B0); PG8_BAR; PG8_SCHED;
            PG8_STAGE(PG8_SB(0, 1), b2 + hstep, voffB);
            PG8_WAIT_V(6); PG8_BAR; PG8_MMA(1, 1, At, B1); PG8_BAR;
            PG8_LDB(B0, 1, 0); PG8_SCHED; PG8_LDA(At, 1, 0); PG8_STAGE(PG8_SA(0, 1), a2 + hstep, voffA);
            PG8_WAIT_L(8); PG8_BAR; PG8_WAIT_L(0); PG8_MMA(0, 0, At, B0); PG8_BAR; PG8_SCHED;
            PG8_LDB(B1, 1, 1); PG8_STAGE(PG8_SB(1, 0), b3, voffB);
            PG8_BAR; PG8_WAIT_L(0); PG8_MMA(0, 1, At, B1); PG8_BAR;
            PG8_LDA(At, 1, 1); PG8_STAGE(PG8_SA(1, 0), a3, voffA);
            PG8_BAR; PG8_WAIT_L(0); PG8_MMA(1, 0, At, B0); PG8_BAR; PG8_SCHED;
            PG8_STAGE(PG8_SB(1, 1), b3 + hstep, voffB);
            PG8_WAIT_V(6); PG8_BAR; PG8_MMA(1, 1, At, B1); PG8_BAR;
            }
        }
        if constexpr (ALIGN_EPI) { if (wr == 0) PG8_BAR; }
        if constexpr (!Epi::AFTER_DRAIN) { E(acc, cur, wr, wc, fr, fq); S.done(cur); }
        if (!has_next) break;
#pragma unroll
        for (int a = 0; a < 2; ++a)
#pragma unroll
            for (int b = 0; b < 2; ++b)
#pragma unroll
                for (int m = 0; m < 4; ++m)
#pragma unroll
                    for (int n = 0; n < 2; ++n) acc[a][b][m][n] = (f32x4){0.f, 0.f, 0.f, 0.f};
        cur = nxt; cA = nA; cB = nB; ++ui;
        if constexpr (ALIGN_EPI) { if (wr == 1) PG8_BAR; }
    }
    PG8_WAIT_V(0);
    if constexpr (!ALIGN_EPI) { if (wr == 0) PG8_BAR; }
    PG8_BAR;
    if constexpr (Epi::AFTER_DRAIN) { E.fused(acc, cur, wr, wc, fr, fq, lds, wid, lane); S.done(cur); }
#undef PG8_SA
#undef PG8_SB
#undef PG8_STAGE
#undef PG8_LDA
#undef PG8_LDB
#undef PG8_MMA
#undef PG8_WAIT_V
#undef PG8_WAIT_L
#undef PG8_BAR
#undef PG8_SCHED
}
}
constexpr int NWAVES = 8;
constexpr int BATCH = 4, SEQ = 8192, D = 1024, FF = 2816, NIN = 3584;
constexpr int M = BATCH * SEQ;
constexpr float NORM_EPS = 1e-6f;
constexpr size_t MiB = 1u << 20;
constexpr size_t WS_CTL = 0, CTL_ZERO_BYTES = 1 * MiB;
constexpr size_t WS_SS1 = 256 * 1024, WS_SS2 = 384 * 1024, WS_SS3 = 512 * 1024;
constexpr size_t WS_SS0 = 1 * MiB;
constexpr size_t WS_COS = 2 * MiB, WS_SIN = 4 * MiB;
constexpr size_t WS_WGU1 = 6 * MiB, WS_WD1 = 17 * MiB, WS_WIN = 23 * MiB, WS_WOUT = 30 * MiB, WS_WGU2 = 32 * MiB, WS_WD2 = 43 * MiB;
constexpr size_t WS_XB = 50 * MiB;
constexpr size_t WS_UA = 114 * MiB;
constexpr size_t WS_MIX = 338 * MiB;
constexpr size_t WS_ATT = 402 * MiB;
constexpr size_t WS_END = 502 * MiB;
static_assert(WS_WD2 + (size_t)D * FF * 2 <= WS_XB && WS_XB + (size_t)M * D * 2 <= WS_UA && WS_UA + (size_t)M * NIN * 2 <= WS_MIX && WS_MIX + (size_t)M * D * 2 <= WS_ATT, "d_ws map");
constexpr int CW_TMO = 0, CW_CODE = 1;
constexpr int CW_BAR = 4096;
constexpr int RING_OFF = 0, RING_BYTES = 131072;
constexpr int LDSCTL_OFF = RING_BYTES, MISC_OFF = LDSCTL_OFF + 320;
constexpr int LDS_BYTES = 147456;
constexpr int N_PHASES = 9;
struct Args { const float* in[14]; float* out; unsigned char* ws; int ph_lo, ph_hi, li, pad; };
#define GAS __attribute__((address_space(1)))
#define LAS __attribute__((address_space(3)))
typedef unsigned short bf16;
typedef unsigned v4u __attribute__((ext_vector_type(4)));
typedef float f32x4 __attribute__((ext_vector_type(4)));
typedef short bf16x8 __attribute__((ext_vector_type(8)));
typedef GAS unsigned gu32;
typedef GAS unsigned long long gu64;
#define RLX_AGENT __ATOMIC_RELAXED, __HIP_MEMORY_SCOPE_AGENT
#define LDS_WAIT() asm volatile("s_waitcnt lgkmcnt(0)" ::: "memory")
#define VM_WAIT() asm volatile("s_waitcnt vmcnt(0)" ::: "memory")
__device__ __forceinline__ unsigned long long rt() { return __builtin_amdgcn_s_memrealtime(); }
__device__ __forceinline__ unsigned f2bf(float f) { unsigned u = __builtin_bit_cast(unsigned, f); return (u + 0x7fffu + ((u >> 16) & 1u)) >> 16; }
__device__ __forceinline__ unsigned pk2(float lo, float hi) { return f2bf(lo) | (f2bf(hi) << 16); }

#define XB_TMO      128
#define XB_XCNT(j)  (256  + 64 * (j))
#define XB_XSUB(j)  (1280 + 64 * (j))
#define XB_XGEN(j)  (2304 + 64 * (j))
#define XB_TOP      3328
#define XB_TOPGEN   3392
#define XCD_BAR_WORDS 3456
#define XB_SPIN_CAP (1u << 18)

__device__ __forceinline__ unsigned xb_ld(unsigned* p)              { return __hip_atomic_load(p, __ATOMIC_RELAXED, __HIP_MEMORY_SCOPE_AGENT); }
__device__ __forceinline__ unsigned xb_add(unsigned* p, unsigned v) { return __hip_atomic_fetch_add(p, v, __ATOMIC_RELAXED, __HIP_MEMORY_SCOPE_AGENT); }
__device__ __forceinline__ unsigned xb_xcc_id() { return (unsigned)__builtin_amdgcn_s_getreg((3 << 11) | 20) & 0xFu; }
#define XB_SPIN(cond, bar) do { unsigned _sp = 0; while (cond) { __builtin_amdgcn_s_sleep(1); \
    if ((++_sp & 255u) == 0u) { if (xb_ld(&(bar)[XB_TMO])) break; if (_sp > XB_SPIN_CAP) { atomicAdd(&(bar)[XB_TMO], 1u); break; } } } } while (0)

struct XcdBarrier {
    unsigned* bar; unsigned x;
    volatile LAS unsigned* st;
};

__device__ __forceinline__ XcdBarrier xcd_barrier_post(unsigned* bar, volatile LAS unsigned* st) {
    XcdBarrier b; b.bar = bar; b.x = xb_xcc_id(); b.st = st;
    if (threadIdx.x == 0) (void)xb_add(&bar[XB_XCNT(b.x)], 1u);
    return b;
}
__device__ __forceinline__ void xcd_barrier_complete(unsigned* bar, unsigned x, unsigned& nloc, unsigned& nx) {
    const unsigned G = gridDim.x * gridDim.y * gridDim.z;
    unsigned sum, cnt, mine, sp = 0u;
    for (;;) {
        sum = 0u; cnt = 0u; mine = 0u;
#pragma unroll
        for (unsigned j = 0; j < 16; ++j) { const unsigned c = xb_ld(&bar[XB_XCNT(j)]); sum += c; cnt += (c > 0u) ? 1u : 0u; mine = (j == x) ? c : mine; }
        if (sum == G) break;
        __builtin_amdgcn_s_sleep(1);
        if ((++sp & 255u) == 0u) { if (xb_ld(&bar[XB_TMO])) break; if (sp > XB_SPIN_CAP) { atomicAdd(&bar[XB_TMO], 1u); break; } }
    }
    nloc = mine > 0u ? mine : 1u; nx = cnt > 0u ? cnt : 1u;
}

__device__ __forceinline__ void xcd_barrier(const XcdBarrier& b) {
    asm volatile("s_waitcnt vmcnt(0)" ::: "memory");
    __syncthreads();
    if (threadIdx.x == 0) {
        unsigned* bar = b.bar;
        __builtin_amdgcn_s_waitcnt(0);
        unsigned nloc = b.st[0], nx = b.st[1];
        if (nloc == 0u) { xcd_barrier_complete(bar, b.x, nloc, nx); b.st[0] = nloc; b.st[1] = nx; }
        const unsigned old = xb_add(&bar[XB_XSUB(b.x)], 1u);
        const unsigned gen = old / nloc;
        if (old + 1u == (gen + 1u) * nloc) {
            __builtin_amdgcn_fence(__ATOMIC_RELEASE, "agent");
            asm volatile("s_waitcnt vmcnt(0)" ::: "memory");
            const unsigned og = xb_add(&bar[XB_TOP], 1u);
            const unsigned tg = og / nx;
            if (og + 1u == (tg + 1u) * nx) xb_add(&bar[XB_TOPGEN], 1u);
            else XB_SPIN(xb_ld(&bar[XB_TOPGEN]) == tg, bar);
            __builtin_amdgcn_fence(__ATOMIC_ACQUIRE, "agent");
            xb_add(&bar[XB_XGEN(b.x)], 1u);
            asm volatile("s_waitcnt vmcnt(0)" ::: "memory");
        } else {
            XB_SPIN(xb_ld(&bar[XB_XGEN(b.x)]) == gen, bar);
            __builtin_amdgcn_fence(__ATOMIC_ACQUIRE, "agent");
            asm volatile("s_waitcnt vmcnt(0)" ::: "memory");
        }
    }
    __syncthreads();
}
struct Frame {
    LAS unsigned char* lds;
    volatile LAS unsigned* MISC;
    gu32* ctl;
    int tid, lane, wave;
    int vcu, G;
};
__device__ __forceinline__ float wave_sum(float v) {
#pragma unroll
    for (int o = 1; o < 64; o <<= 1) v += __shfl_xor(v, o);
    return v;
}
__device__ __forceinline__ float bf2f(unsigned short b) { return __uint_as_float((unsigned)b << 16); }

typedef short v4i16_t __attribute__((ext_vector_type(4)));
typedef short s16x4 __attribute__((ext_vector_type(4)));
constexpr float LOG2E = 1.4426950408889634f, LN2 = 0.6931471805599453f;
constexpr int AP = 144;
constexpr int A_K = 0, A_V = 256 * AP;
constexpr int RP = 272;
constexpr int R_K = 0, R_V = 128 * RP, R_S = 256 * RP;
static_assert(A_V + 256 * AP <= RING_BYTES && R_S + 128 * RP <= RING_BYTES, "mixer LDS");
constexpr size_t WS_KV = WS_XB;
constexpr size_t WS_OP = WS_ATT, WS_LSE = WS_ATT + 96 * MiB;
static_assert(WS_LSE + 3 * (size_t)M * 8 * 4 <= WS_END, "mixer ws");

__device__ __forceinline__ s16x4 tr_read4(LAS unsigned char* p) { return __builtin_bit_cast(s16x4, __builtin_amdgcn_ds_read_tr16_b64_v4i16((LAS v4i16_t*)p)); }
__device__ __forceinline__ bf16x8 tr_frag(LAS unsigned char* p0, LAS unsigned char* p1) { const s16x4 a = tr_read4(p0), b = tr_read4(p1); return (bf16x8){a[0], a[1], a[2], a[3], b[0], b[1], b[2], b[3]}; }
__device__ __forceinline__ bf16x8 pack8(const f32x4& a, const f32x4& b) {
    v4u w; w.x = pg8::cvtpk_m(a[0], a[1]); w.y = pg8::cvtpk_m(a[2], a[3]); w.z = pg8::cvtpk_m(b[0], b[1]); w.w = pg8::cvtpk_m(b[2], b[3]); return __builtin_bit_cast(bf16x8, w); }
#define MFMA16(a, b, c) __builtin_amdgcn_mfma_f32_16x16x32_bf16((a), (b), (c), 0, 0, 0)

__device__ __forceinline__ void attn_unit(Frame& F, const bf16* U, bf16* OP, float* LSE, int unit) {
    const int bh = unit / 192; int r = unit % 192; int p, g, n, dil;
    if (r < 64) { p = 0; dil = 1; g = 0; n = r; } else if (r < 128) { r -= 64; p = 1; dil = 4; g = r >> 4; n = r & 15; } else { r -= 128; p = 2; dil = 16; g = r >> 2; n = r & 3; }
    const int b = bh >> 3, h = bh & 7;
    const bf16* Ub = U + (size_t)b * SEQ * NIN;
    const int lane = F.lane, w = F.wave, g4 = lane >> 4, l15 = lane & 15, qq = l15 >> 2, pp = lane & 3;
#pragma unroll
    for (int i = 0; i < 4; ++i) {
        const int chunk = F.tid + 512 * i, kj = chunk >> 3, c16 = chunk & 7; const int tk = g + dil * (128 * (n - 1) + kj);
        v4u kv = (v4u){0u, 0u, 0u, 0u}, vv = (v4u){0u, 0u, 0u, 0u};
        if (tk >= 0) { kv = *(const GAS v4u*)(Ub + (size_t)tk * NIN + 2560 + h * 64 + c16 * 8); vv = *(const GAS v4u*)(Ub + (size_t)tk * NIN + 3072 + h * 64 + c16 * 8); }
        *(LAS v4u*)(F.lds + A_K + kj * AP + c16 * 16) = kv; *(LAS v4u*)(F.lds + A_V + kj * AP + c16 * 16) = vv;
    }
    const int qi = 16 * w + l15; const int tq = g + dil * (128 * n + qi);
    bf16x8 qf[2];
#pragma unroll
    for (int ks = 0; ks < 2; ++ks) qf[ks] = *(const GAS bf16x8*)(Ub + (size_t)tq * NIN + 2048 + h * 64 + 32 * ks + 8 * g4);
    __syncthreads();
    const int kb0 = 32 * (w >> 1);
    f32x4 s[10];
#pragma unroll
    for (int kt = 0; kt < 10; ++kt) { s[kt] = (f32x4){0.f, 0.f, 0.f, 0.f};
#pragma unroll
        for (int ks = 0; ks < 2; ++ks) { const bf16x8 a = *(const LAS bf16x8*)(F.lds + A_K + (kb0 + 16 * kt + l15) * AP + (32 * ks + 8 * g4) * 2); s[kt] = MFMA16(a, qf[ks], s[kt]); } }
    float mx = -INFINITY;
#pragma unroll
    for (int kt = 0; kt < 10; ++kt)
#pragma unroll
        for (int rr = 0; rr < 4; ++rr) { const int kj = kb0 + 16 * kt + 4 * g4 + rr; const bool ok = (kj >= qi) && (kj <= qi + 128) && (128 * (n - 1) + kj >= 0);
            const float v = ok ? s[kt][rr] * LOG2E : -INFINITY; s[kt][rr] = v; mx = fmaxf(mx, v); }
    mx = fmaxf(mx, __shfl_xor(mx, 16)); mx = fmaxf(mx, __shfl_xor(mx, 32));
    float lsum = 0.f;
#pragma unroll
    for (int kt = 0; kt < 10; ++kt)
#pragma unroll
        for (int rr = 0; rr < 4; ++rr) { const float e = __builtin_amdgcn_exp2f(s[kt][rr] - mx); s[kt][rr] = e; lsum += e; }
    lsum += __shfl_xor(lsum, 16); lsum += __shfl_xor(lsum, 32);
    bf16x8 pb[5];
#pragma unroll
    for (int kk = 0; kk < 5; ++kk) pb[kk] = pack8(s[2 * kk], s[2 * kk + 1]);
    f32x4 o[4];
#pragma unroll
    for (int dt = 0; dt < 4; ++dt) { o[dt] = (f32x4){0.f, 0.f, 0.f, 0.f};
#pragma unroll
        for (int kk = 0; kk < 5; ++kk) { LAS unsigned char* vp = F.lds + A_V + (kb0 + 32 * kk + 4 * g4 + qq) * AP + (16 * dt + 4 * pp) * 2;
            const bf16x8 a = tr_frag(vp, vp + 16 * AP); o[dt] = MFMA16(a, pb[kk], o[dt]); } }
    const float inv = 1.0f / lsum; const size_t tok = (size_t)b * SEQ + tq;
    bf16* op = OP + ((size_t)p * M + tok) * 512 + h * 64 + 4 * g4;
#pragma unroll
    for (int dt = 0; dt < 4; ++dt) { const f32x4 v = o[dt] * inv; unsigned long long wv = (unsigned long long)pg8::cvtpk_m(v[0], v[1]) | ((unsigned long long)pg8::cvtpk_m(v[2], v[3]) << 32);
        *(GAS unsigned long long*)(op + 16 * dt) = wv; }
    if (g4 == 0) LSE[((size_t)p * M + tok) * 8 + h] = mx * LN2 + __logf(lsum);
    __syncthreads();
}

__device__ __forceinline__ void attn_combine(Frame& F, const bf16* OP, const float* LSE, bf16* MIX) {
    const int gw = F.vcu * NWAVES + F.wave, NGW = F.G * NWAVES; const int h = F.lane >> 3;
    for (int t = gw; t < M; t += NGW) {
        float l0 = LSE[((size_t)0 * M + t) * 8 + h], l1 = LSE[((size_t)1 * M + t) * 8 + h], l2 = LSE[((size_t)2 * M + t) * 8 + h];
        const float mx = fmaxf(l0, fmaxf(l1, l2));
        float w0 = __expf(l0 - mx), w1 = __expf(l1 - mx), w2 = __expf(l2 - mx); const float inv = 1.0f / (w0 + w1 + w2); w0 *= inv; w1 *= inv; w2 *= inv;
        const v4u a = *(const GAS v4u*)(OP + ((size_t)0 * M + t) * 512 + F.lane * 8), bq = *(const GAS v4u*)(OP + ((size_t)1 * M + t) * 512 + F.lane * 8), c = *(const GAS v4u*)(OP + ((size_t)2 * M + t) * 512 + F.lane * 8);
        v4u o;
#pragma unroll
        for (int j = 0; j < 4; ++j) { const unsigned x = a[j], y = bq[j], z = c[j];
            const float lo = w0 * __uint_as_float(x << 16) + w1 * __uint_as_float(y << 16) + w2 * __uint_as_float(z << 16);
            const float hi = w0 * __uint_as_float(x & 0xffff0000u) + w1 * __uint_as_float(y & 0xffff0000u) + w2 * __uint_as_float(z & 0xffff0000u);
            o[j] = pg8::cvtpk_m(lo, hi); }
        *(GAS v4u*)(MIX + (size_t)t * D + 512 + F.lane * 8) = o;
    }
}

__device__ __forceinline__ void kv_unit(Frame& F, const bf16* U, bf16* KV, int unit) {
    const int bh = unit >> 6, n = unit & 63, b = bh >> 2, h = bh & 3; const size_t t0 = (size_t)b * SEQ + 128 * n;
    const int lane = F.lane, w = F.wave, g4 = lane >> 4, l15 = lane & 15, qq = l15 >> 2, pp = lane & 3;
    const float log2g = __log2f(1.0f - exp2f(-5.0f - (float)h));
#pragma unroll
    for (int i = 0; i < 4; ++i) {
        const int chunk = F.tid + 512 * i, m = chunk >> 4, c16 = chunk & 15;
        const v4u kr = *(const GAS v4u*)(U + (t0 + m) * NIN + 512 + h * 128 + c16 * 8), vv = *(const GAS v4u*)(U + (t0 + m) * NIN + 1024 + h * 128 + c16 * 8);
        const float z = __builtin_amdgcn_exp2f((float)(127 - m) * log2g);
        v4u kz;
#pragma unroll
        for (int j = 0; j < 4; ++j) kz[j] = pg8::cvtpk_m(__uint_as_float(kr[j] << 16) * z, __uint_as_float(kr[j] & 0xffff0000u) * z);
        *(LAS v4u*)(F.lds + R_K + m * RP + c16 * 16) = kz; *(LAS v4u*)(F.lds + R_V + m * RP + c16 * 16) = vv;
    }
    __syncthreads();
    bf16x8 af[4];
#pragma unroll
    for (int ks = 0; ks < 4; ++ks) { LAS unsigned char* kp = F.lds + R_K + (32 * ks + 8 * g4 + qq) * RP + (16 * w + 4 * pp) * 2; af[ks] = tr_frag(kp, kp + 4 * RP); }
    bf16* out = KV + (size_t)unit * 16384;
#pragma unroll
    for (int et = 0; et < 8; ++et) {
        f32x4 acc = (f32x4){0.f, 0.f, 0.f, 0.f};
#pragma unroll
        for (int ks = 0; ks < 4; ++ks) { LAS unsigned char* vp = F.lds + R_V + (32 * ks + 8 * g4 + qq) * RP + (16 * et + 4 * pp) * 2; const bf16x8 bfr = tr_frag(vp, vp + 4 * RP); acc = MFMA16(af[ks], bfr, acc); }
        const unsigned long long wv = (unsigned long long)pg8::cvtpk_m(acc[0], acc[1]) | ((unsigned long long)pg8::cvtpk_m(acc[2], acc[3]) << 32);
        *(GAS unsigned long long*)(out + (size_t)(16 * et + l15) * 128 + 16 * w + 4 * g4) = wv;
    }
    __syncthreads();
}

__device__ __forceinline__ void scan_phase(Frame& F, bf16* KV) {
    const int gt = F.vcu * (NWAVES * 64) + F.tid, NGT = F.G * NWAVES * 64;
    for (int e = gt; e < 16 * 8192; e += NGT) {
        const int bh = e >> 13, pr = e & 8191, h = bh & 3;
        const float cd = exp2f(128.0f * __log2f(1.0f - exp2f(-5.0f - (float)h)));
        GAS unsigned* p = (GAS unsigned*)(KV + (size_t)bh * 64 * 16384) + pr;
        float s0 = 0.f, s1 = 0.f;
        for (int n0 = 0; n0 < 64; n0 += 8) {
            unsigned kvv[8];
#pragma unroll
            for (int j = 0; j < 8; ++j) kvv[j] = p[(size_t)(n0 + j) * 8192];
#pragma unroll
            for (int j = 0; j < 8; ++j) { p[(size_t)(n0 + j) * 8192] = pg8::cvtpk_m(s0, s1);
                s0 = s0 * cd + __uint_as_float(kvv[j] << 16); s1 = s1 * cd + __uint_as_float(kvv[j] & 0xffff0000u); }
        }
    }
}

__device__ __forceinline__ void ret_unit(Frame& F, const bf16* U, const bf16* ST, const float* gain, bf16* MIX, int unit) {
    const int bh = unit >> 6, n = unit & 63, b = bh >> 2, h = bh & 3; const size_t t0 = (size_t)b * SEQ + 128 * n;
    const int lane = F.lane, w = F.wave, g4 = lane >> 4, l15 = lane & 15, qq = l15 >> 2, pp = lane & 3;
    const float log2g = __log2f(1.0f - exp2f(-5.0f - (float)h));
    const bf16* st = ST + (size_t)unit * 16384;
#pragma unroll
    for (int i = 0; i < 4; ++i) {
        const int chunk = F.tid + 512 * i, m = chunk >> 4, c16 = chunk & 15;
        const v4u kr = *(const GAS v4u*)(U + (t0 + m) * NIN + 512 + h * 128 + c16 * 8), vv = *(const GAS v4u*)(U + (t0 + m) * NIN + 1024 + h * 128 + c16 * 8), sv = *(const GAS v4u*)(st + m * 128 + c16 * 8);
        *(LAS v4u*)(F.lds + R_K + m * RP + c16 * 16) = kr; *(LAS v4u*)(F.lds + R_V + m * RP + c16 * 16) = vv; *(LAS v4u*)(F.lds + R_S + m * RP + c16 * 16) = sv;
    }
    const int c = 16 * w + l15; const size_t tq = t0 + c;
    bf16x8 qf[4];
#pragma unroll
    for (int ks = 0; ks < 4; ++ks) qf[ks] = *(const GAS bf16x8*)(U + tq * NIN + h * 128 + 32 * ks + 8 * g4);
    __syncthreads();
    f32x4 sa[8];
#pragma unroll
    for (int mt = 0; mt < 8; ++mt) { sa[mt] = (f32x4){0.f, 0.f, 0.f, 0.f};
        if (mt <= w) {
#pragma unroll
            for (int ks = 0; ks < 4; ++ks) { const bf16x8 a = *(const LAS bf16x8*)(F.lds + R_K + (16 * mt + l15) * RP + (32 * ks + 8 * g4) * 2); sa[mt] = MFMA16(a, qf[ks], sa[mt]); } } }
#pragma unroll
    for (int mt = 0; mt < 8; ++mt)
#pragma unroll
        for (int rr = 0; rr < 4; ++rr) { const int m = 16 * mt + 4 * g4 + rr; sa[mt][rr] = (m <= c) ? sa[mt][rr] * __builtin_amdgcn_exp2f((float)(c - m) * log2g) : 0.f; }
    bf16x8 pb[4];
#pragma unroll
    for (int kk = 0; kk < 4; ++kk) pb[kk] = pack8(sa[2 * kk], sa[2 * kk + 1]);
    f32x4 ia[8], ie[8];
#pragma unroll
    for (int et = 0; et < 8; ++et) { ia[et] = (f32x4){0.f, 0.f, 0.f, 0.f}; ie[et] = (f32x4){0.f, 0.f, 0.f, 0.f};
#pragma unroll
        for (int kk = 0; kk < 4; ++kk) if (2 * kk <= w) { LAS unsigned char* vp = F.lds + R_V + (32 * kk + 4 * g4 + qq) * RP + (16 * et + 4 * pp) * 2; const bf16x8 a = tr_frag(vp, vp + 16 * RP); ia[et] = MFMA16(a, pb[kk], ia[et]); }
#pragma unroll
        for (int ks = 0; ks < 4; ++ks) { const bf16x8 a = *(const LAS bf16x8*)(F.lds + R_S + (16 * et + l15) * RP + (32 * ks + 8 * g4) * 2); ie[et] = MFMA16(a, qf[ks], ie[et]); } }
    const float xi = __builtin_amdgcn_exp2f((float)(c + 1) * log2g);
    float sum = 0.f;
#pragma unroll
    for (int et = 0; et < 8; ++et) { ia[et] = ia[et] + ie[et] * xi; sum += (ia[et][0] + ia[et][1]) + (ia[et][2] + ia[et][3]); }
    sum += __shfl_xor(sum, 16); sum += __shfl_xor(sum, 32);
    const float mu = sum * (1.0f / 128.0f); float var = 0.f;
#pragma unroll
    for (int et = 0; et < 8; ++et) { ia[et] = ia[et] - mu; var += (ia[et][0] * ia[et][0] + ia[et][1] * ia[et][1]) + (ia[et][2] * ia[et][2] + ia[et][3] * ia[et][3]); }
    var += __shfl_xor(var, 16); var += __shfl_xor(var, 32);
    const float rstd = 1.0f / sqrtf(var * (1.0f / 128.0f) + 1e-6f);
#pragma unroll
    for (int et = 0; et < 8; ++et) { const int e = 16 * et + 4 * g4;
        const f32x4 gn = *(const GAS f32x4*)(gain + h * 128 + e);
        const unsigned long long gw = *(const GAS unsigned long long*)(U + tq * NIN + 1536 + h * 128 + e);
        const float r0 = __uint_as_float((unsigned)gw << 16), r1 = __uint_as_float((unsigned)gw & 0xffff0000u), r2 = __uint_as_float((unsigned)(gw >> 32) << 16), r3 = __uint_as_float((unsigned)(gw >> 32) & 0xffff0000u);
        const float o0 = ia[et][0] * rstd * gn[0] * pg8::silu_fast(r0), o1 = ia[et][1] * rstd * gn[1] * pg8::silu_fast(r1), o2 = ia[et][2] * rstd * gn[2] * pg8::silu_fast(r2), o3 = ia[et][3] * rstd * gn[3] * pg8::silu_fast(r3);
        *(GAS unsigned long long*)(MIX + tq * D + h * 128 + e) = (unsigned long long)pg8::cvtpk_m(o0, o1) | ((unsigned long long)pg8::cvtpk_m(o2, o3) << 32); }
    __syncthreads();
}

__device__ __forceinline__ void mixer_phase(Frame& F, const Args& args, const XcdBarrier& bar) {
    unsigned char* ws = args.ws;
    const bf16* U = (const bf16*)(ws + WS_UA); bf16* KV = (bf16*)(ws + WS_KV); bf16* OP = (bf16*)(ws + WS_OP); float* LSE = (float*)(ws + WS_LSE); bf16* MIX = (bf16*)(ws + WS_MIX);
    { const int per = (1024 + F.G - 1) / F.G; for (int u = F.vcu * per; u < 1024 && u < (F.vcu + 1) * per; ++u) kv_unit(F, U, KV, u); }
    { const int per = (6144 + F.G - 1) / F.G; for (int u = F.vcu * per; u < 6144 && u < (F.vcu + 1) * per; ++u) attn_unit(F, U, OP, LSE, u); }
    xcd_barrier(bar);
    scan_phase(F, KV);
    xcd_barrier(bar);
    { const int per = (1024 + F.G - 1) / F.G; for (int u = F.vcu * per; u < 1024 && u < (F.vcu + 1) * per; ++u) ret_unit(F, U, KV, args.in[7], MIX, u); }
    attn_combine(F, OP, LSE, MIX);
}
__device__ __forceinline__ void p0_transpose_item(const float* W, int K, int N, bf16* WT, const float* gain, int mode, LAS float* scr, int item, int lane) {
    const int nblk = N / 32, kb = item / nblk, nb = item % nblk, k0 = 64 * kb, n0 = 32 * nb;
#pragma unroll 8
    for (int i = 0; i < 32; ++i) { const int kk = 2 * i + (lane >> 5); float w = W[(size_t)(k0 + kk) * N + n0 + (lane & 31)]; if (gain) w *= gain[k0 + kk]; scr[kk * 33 + (lane & 31)] = w; }
    LDS_WAIT(); asm volatile("" ::: "memory");
    const int c = lane & 7;
    const int drow0 = (mode == 0) ? n0 : ((n0 >> 7) * 256 + (n0 & 127) + (mode == 2 ? 128 : 0));
#pragma unroll
    for (int j = 0; j < 4; ++j) { const int n = (lane >> 3) + 8 * j; const LAS float* s = scr + (8 * c) * 33 + n;
        v4u o; o.x = pk2(s[0 * 33], s[1 * 33]); o.y = pk2(s[2 * 33], s[3 * 33]); o.z = pk2(s[4 * 33], s[5 * 33]); o.w = pk2(s[6 * 33], s[7 * 33]);
        *(GAS v4u*)(WT + (size_t)(drow0 + n) * K + k0 + 8 * c) = o; }
    LDS_WAIT(); asm volatile("" ::: "memory");
}


__device__ __forceinline__ void p0_prologue(Frame& F, const Args& args) {
    unsigned char* ws = args.ws;
    LAS float* scr = (LAS float*)(F.lds + RING_OFF + F.wave * 16384);
    const int gw = F.vcu * NWAVES + F.wave, NGW = F.G * NWAVES;
    constexpr int I_GU = (D / 64) * (FF / 32), I_DN = (FF / 64) * (D / 32), I_IN = (D / 64) * (NIN / 32), I_OUT = (D / 64) * (D / 32);
    constexpr int NITEMS = 4 * I_GU + 2 * I_DN + I_IN + I_OUT;
    for (int it = gw; it < NITEMS; it += NGW) {
        int r = it;
        if (r < I_GU) { p0_transpose_item(args.in[2], D, FF, (bf16*)(ws + WS_WGU1), args.in[1], 1, scr, r, F.lane); continue; } r -= I_GU;
        if (r < I_GU) { p0_transpose_item(args.in[3], D, FF, (bf16*)(ws + WS_WGU1), args.in[1], 2, scr, r, F.lane); continue; } r -= I_GU;
        if (r < I_DN) { p0_transpose_item(args.in[4], FF, D, (bf16*)(ws + WS_WD1), nullptr, 0, scr, r, F.lane); continue; } r -= I_DN;
        if (r < I_IN) { p0_transpose_item(args.in[6], D, NIN, (bf16*)(ws + WS_WIN), args.in[5], 0, scr, r, F.lane); continue; } r -= I_IN;
        if (r < I_OUT) { p0_transpose_item(args.in[8], D, D, (bf16*)(ws + WS_WOUT), nullptr, 0, scr, r, F.lane); continue; } r -= I_OUT;
        if (r < I_GU) { p0_transpose_item(args.in[10], D, FF, (bf16*)(ws + WS_WGU2), args.in[9], 1, scr, r, F.lane); continue; } r -= I_GU;
        if (r < I_GU) { p0_transpose_item(args.in[11], D, FF, (bf16*)(ws + WS_WGU2), args.in[9], 2, scr, r, F.lane); continue; } r -= I_GU;
        p0_transpose_item(args.in[12], FF, D, (bf16*)(ws + WS_WD2), nullptr, 0, scr, r, F.lane);
    }
    {
        const float* x = args.in[0]; bf16* xb = (bf16*)(ws + WS_XB); float* ss0 = (float*)(ws + WS_SS0);
        for (int m = gw; m < M; m += NGW) {
            const GAS f32x4* xr = (const GAS f32x4*)(x + (size_t)m * D) + F.lane;
            f32x4 v[4]; float s = 0.f;
#pragma unroll
            for (int j = 0; j < 4; ++j) { v[j] = xr[64 * j]; s += (v[j].x * v[j].x + v[j].y * v[j].y) + (v[j].z * v[j].z + v[j].w * v[j].w); }
            s = wave_sum(s);
            GAS unsigned long long* o8 = (GAS unsigned long long*)(xb + (size_t)m * D) + F.lane;
#pragma unroll
            for (int j = 0; j < 4; ++j) o8[64 * j] = (unsigned long long)pk2(v[j].x, v[j].y) | ((unsigned long long)pk2(v[j].z, v[j].w) << 32);
            if (F.lane == 0) ss0[m] = s;
        }
    }
    {
        float* cosT = (float*)(ws + WS_COS); float* sinT = (float*)(ws + WS_SIN);
        const int gt = F.vcu * (NWAVES * 64) + F.tid, NGT = F.G * NWAVES * 64;
        for (int e = gt; e < SEQ * 64; e += NGT) {
            const int s = e >> 6, i = e & 63;
            const float inv = powf(10000.0f, -(float)(2 * i) / 128.0f);
            const float ang = (float)s * inv;
            cosT[e] = cosf(ang); sinT[e] = sinf(ang);
        }
    }
}

__device__ __forceinline__ void p8_final(Frame& F, const Args& args) {
    const int gw = F.vcu * NWAVES + F.wave, NGW = F.G * NWAVES;
    const float* ss3 = (const float*)(args.ws + WS_SS3); const float* g = args.in[13];
    f32x4 gv[4];
#pragma unroll
    for (int j = 0; j < 4; ++j) gv[j] = ((const GAS f32x4*)g)[F.lane + 64 * j];
    for (int m = gw; m < M; m += NGW) {
        GAS f32x4* xr = (GAS f32x4*)(args.out + (size_t)m * D) + F.lane;
        const float rs = 1.0f / sqrtf(ss3[m] * (1.0f / 1024.0f) + NORM_EPS);
#pragma unroll
        for (int j = 0; j < 4; ++j) { f32x4 v = xr[64 * j]; v = v * rs * gv[j]; xr[64 * j] = v; }
    }
}

__global__ void __launch_bounds__(NWAVES * 64, 2) mk_fwd(Args args) {
    extern __shared__ __attribute__((aligned(16))) unsigned char lds[];
    Frame F;
    F.lds = (LAS unsigned char*)lds;
    F.MISC = (volatile LAS unsigned*)(F.lds + MISC_OFF);
    F.tid = threadIdx.x; F.lane = F.tid & 63; F.wave = __builtin_amdgcn_readfirstlane(F.tid >> 6);
    F.G = gridDim.x; { const int bx = blockIdx.x; F.vcu = (F.G % 8 == 0) ? (bx % 8) * (F.G / 8) + bx / 8 : bx; }
    unsigned char* ws = args.ws;
    F.ctl = (gu32*)(ws + WS_CTL);
    for (int u = F.tid; u < (LDS_BYTES - LDSCTL_OFF) / 4; u += NWAVES * 64) ((LAS unsigned*)(F.lds + LDSCTL_OFF))[u] = 0u;
    __syncthreads();
    XcdBarrier bar = xcd_barrier_post((unsigned*)(F.ctl + CW_BAR) + args.li * XCD_BAR_WORDS, F.MISC + 8);
#define GRID_BAR() xcd_barrier(bar)
    const int lo = args.ph_lo, hi = args.ph_hi;
#define IN(k) (lo <= (k) && (k) < hi)
#define BOTH(k) (IN(k) && IN((k) + 1))
    bf16* XB = (bf16*)(ws + WS_XB); bf16* UA = (bf16*)(ws + WS_UA); bf16* MIX = (bf16*)(ws + WS_MIX);
    float* SS0 = (float*)(ws + WS_SS0); float* SS1 = (float*)(ws + WS_SS1); float* SS2 = (float*)(ws + WS_SS2); float* SS3 = (float*)(ws + WS_SS3);

    if (IN(0)) { p0_prologue(F, args); if (BOTH(0)) GRID_BAR(); }
    if (IN(1)) {
        pg8::Gemm g{XB, (const bf16*)(ws + WS_WGU1), M, 2 * FF, D}; pg8::StaticOrder S; S.init(M, 2 * FF, F.G, (int)blockIdx.x);
        pg8::EpiSwiGLU E{UA, FF, SS0};
        pg8::gemm_phase<pg8::EpiSwiGLU, pg8::StaticOrder, true, true>(F.lds + RING_OFF, g, S, E);
        if (BOTH(1)) GRID_BAR();
    }
    if (IN(2)) {
        pg8::Gemm g{UA, (const bf16*)(ws + WS_WD1), M, D, FF}; pg8::StaticOrder S; S.init(M, D, F.G, (int)blockIdx.x);
        pg8::EpiResid<true> E{args.in[0], args.out, XB, 0.5f, SS1};
        pg8::gemm_phase<pg8::EpiResid<true>, pg8::StaticOrder, true, true>(F.lds + RING_OFF, g, S, E);
        if (BOTH(2)) GRID_BAR();
    }
    if (IN(3)) {
        pg8::Gemm g{XB, (const bf16*)(ws + WS_WIN), M, NIN, D}; pg8::StaticOrder S; S.init(M, NIN, F.G, (int)blockIdx.x);
        pg8::EpiUProj E{UA, SS1, (const float*)(ws + WS_COS), (const float*)(ws + WS_SIN)};
        pg8::gemm_phase<pg8::EpiUProj, pg8::StaticOrder, true, true>(F.lds + RING_OFF, g, S, E);
        if (BOTH(3)) GRID_BAR();
    }
    if (IN(4)) {
        mixer_phase(F, args, bar);
        if (BOTH(4)) GRID_BAR();
    }
    if (IN(5)) {
        pg8::Gemm g{MIX, (const bf16*)(ws + WS_WOUT), M, D, D}; pg8::StaticOrder S; S.init(M, D, F.G, (int)blockIdx.x);
        pg8::EpiResid<true> E{args.out, args.out, XB, 1.0f, SS2};
        pg8::gemm_phase<pg8::EpiResid<true>, pg8::StaticOrder, true, true>(F.lds + RING_OFF, g, S, E);
        if (BOTH(5)) GRID_BAR();
    }
    if (IN(6)) {
        pg8::Gemm g{XB, (const bf16*)(ws + WS_WGU2), M, 2 * FF, D}; pg8::StaticOrder S; S.init(M, 2 * FF, F.G, (int)blockIdx.x);
        pg8::EpiSwiGLU E{UA, FF, SS2};
        pg8::gemm_phase<pg8::EpiSwiGLU, pg8::StaticOrder, true, true>(F.lds + RING_OFF, g, S, E);
        if (BOTH(6)) GRID_BAR();
    }
    if (IN(7)) {
        pg8::Gemm g{UA, (const bf16*)(ws + WS_WD2), M, D, FF}; pg8::StaticOrder S; S.init(M, D, F.G, (int)blockIdx.x);
        pg8::EpiResid<false> E{args.out, args.out, nullptr, 0.5f, SS3};
        pg8::gemm_phase<pg8::EpiResid<false>, pg8::StaticOrder, true, true>(F.lds + RING_OFF, g, S, E);
        if (BOTH(7)) GRID_BAR();
    }
    if (IN(8)) { p8_final(F, args); }
#undef IN
#undef BOTH
}

extern "C" void kernel_launch(void* const* d_in, const int* in_sizes, int n_in, void* d_out, int out_size, void* d_ws, size_t ws_size, hipStream_t stream) {
    static int grid = 0;
    if (grid == 0) {
        if (n_in != 14 || in_sizes[0] != M * D || out_size != M * D || ws_size < WS_END) { fprintf(stderr, "kernel_launch: unexpected shapes (n_in %d, in0 %d, out %d, ws %zu)\n", n_in, n_in > 0 ? in_sizes[0] : -1, out_size, ws_size); grid = -1; return; }
        int dev = 0, cus = 0;
        if (hipGetDevice(&dev) != hipSuccess || hipDeviceGetAttribute(&cus, hipDeviceAttributeMultiprocessorCount, dev) != hipSuccess) { grid = -1; return; }
        if (hipFuncSetAttribute((const void*)mk_fwd, hipFuncAttributeMaxDynamicSharedMemorySize, LDS_BYTES) != hipSuccess) { fprintf(stderr, "kernel_launch: hipFuncSetAttribute failed\n"); grid = -1; return; }
        int per_cu = 0;
        if (hipOccupancyMaxActiveBlocksPerMultiprocessor(&per_cu, (const void*)mk_fwd, NWAVES * 64, LDS_BYTES) != hipSuccess || per_cu < 1) fprintf(stderr, "kernel_launch: occupancy query says %d\n", per_cu);
        (void)hipGetLastError();
        grid = cus;
    }
    if (grid < 0) return;
    (void)hipMemsetAsync((char*)d_ws + WS_CTL, 0, CTL_ZERO_BYTES, stream);
    Args a{};
    for (int i = 0; i < 14; ++i) a.in[i] = (const float*)d_in[i];
    a.out = (float*)d_out; a.ws = (unsigned char*)d_ws;
    unsigned char* ws = (unsigned char*)d_ws;
    a.ph_lo = 0; a.ph_hi = N_PHASES; a.li = 0;
    hipLaunchKernelGGL(mk_fwd, dim3(grid), dim3(NWAVES * 64), LDS_BYTES, stream, a);
}
```

```cpp
#define DUP 0
#include <hip/hip_runtime.h>
#include <cstdio>
#include <cstdint>
#include <cmath>
namespace pg8 {
#define PG8_LAS __attribute__((address_space(3)))
typedef unsigned short bf16_t;
typedef short bf16x8 __attribute__((ext_vector_type(8)));
typedef float f32x4 __attribute__((ext_vector_type(4)));
typedef unsigned u32x4 __attribute__((ext_vector_type(4)));
constexpr int BM = 256, BK = 64, HALF = 128, HTB = HALF * BK * 2  , STAGE_BYTES = 8 * HTB, NXCD = 8, WGM = 8;

__host__ __device__ __forceinline__ int lds_byte(int r, int c) { const int st = (r >> 4) * 2 + (c >> 5), rr = r & 15, cc = c & 31, ob = rr * 64 + cc * 2; return st * 1024 + (ob ^ (((ob >> 9) & 1) << 5)); }
__host__ __device__ __forceinline__ void stage_rc(int b, int& R, int& C) { const int st = b / 1024, sb = b % 1024, swz = sb ^ (((sb >> 9) & 1) << 5); R = (st >> 1) * 16 + swz / 64; C = (st & 1) * 32 + (swz % 64) / 2; }
__host__ __device__ __forceinline__ int perm32(int rho) { const int n = rho >> 4, i = rho & 15; return 8 * (i >> 2) + 4 * n + (i & 3); }

struct Unit { int pm, pn; };
struct Gemm { const bf16_t* A; const bf16_t* Bt; int M, N, K; };

struct StaticOrder {
    int nM, nN, nwg, G, c;
    __host__ __device__ void init(int M, int N, int G_, int c_) { nM = M / BM; nN = N / BM; nwg = nM * nN; G = G_; c = c_; }
    __host__ __device__ bool next(int i, Unit& u) const {
        const long L = (long)i * G + c; if (L >= nwg) return false;
        int wgid = (int)L; { const int q = nwg / NXCD, r = nwg % NXCD, xcd = wgid % NXCD, off = wgid / NXCD; wgid = (xcd < r ? xcd * (q + 1) : r * (q + 1) + (xcd - r) * q) + off; }
        const int nig = WGM * nN, gid = wgid / nig, fm = gid * WGM, gsz = (nM - fm) < WGM ? (nM - fm) : WGM;
        u.pm = fm + ((wgid % nig) % gsz); u.pn = (wgid % nig) / gsz; return true;
    }
    __device__ __forceinline__ void a_ready(const Unit&) const {}
    __device__ __forceinline__ void done(const Unit&) const {}
};

__device__ __forceinline__ unsigned cvt_pk_bf16(float lo, float hi) { unsigned r; asm volatile("v_cvt_pk_bf16_f32 %0, %1, %2" : "=v"(r) : "v"(lo), "v"(hi)); return r; }
typedef float f32x2 __attribute__((ext_vector_type(2)));
typedef float f32x2_t __attribute__((ext_vector_type(2))); typedef __bf16 bf16x2_t __attribute__((ext_vector_type(2)));
__device__ __forceinline__ unsigned cvtpk_m(float lo, float hi) { f32x2_t v = {lo, hi}; bf16x2_t b = __builtin_convertvector(v, bf16x2_t); return __builtin_bit_cast(unsigned, b); }
__device__ __forceinline__ float fast_rcp(float x) { return __builtin_amdgcn_rcpf(x); }
__device__ __forceinline__ float silu_fast(float v) { return v * fast_rcp(1.0f + __builtin_amdgcn_exp2f(-1.4426950408889634f * v)); }
__device__ __forceinline__ float row_rs(const float* ss, int row) { return 1.0f / sqrtf(ss[row] * (1.0f / 1024.0f) + 1e-6f); }

struct EpiSwiGLU {
    static constexpr bool PERM = true, AFTER_DRAIN = false;
    bf16_t* O; int ldc; const float* ss;
    __device__ __forceinline__ void operator()(const f32x4 (&acc)[2][2][4][2], const Unit& u, int wr, int wc, int fr, int fq) const {
        const int row0 = u.pm * BM + wr * 64 + fr, col0 = u.pn * HALF + wc * 32 + 8 * fq;
#pragma unroll
        for (int ai = 0; ai < 2; ++ai)
#pragma unroll
            for (int m = 0; m < 4; ++m) {
                const int row = row0 + ai * HALF + m * 16; const float rs = row_rs(ss, row);
                const f32x4 g0 = acc[ai][0][m][0] * rs, g1 = acc[ai][0][m][1] * rs, u0 = acc[ai][1][m][0] * rs, u1 = acc[ai][1][m][1] * rs;
                u32x4 w;
                w.x = cvtpk_m(silu_fast(g0[0]) * u0[0], silu_fast(g0[1]) * u0[1]); w.y = cvtpk_m(silu_fast(g0[2]) * u0[2], silu_fast(g0[3]) * u0[3]);
                w.z = cvtpk_m(silu_fast(g1[0]) * u1[0], silu_fast(g1[1]) * u1[1]); w.w = cvtpk_m(silu_fast(g1[2]) * u1[2], silu_fast(g1[3]) * u1[3]);
                *(u32x4*)(O + (size_t)row * ldc + col0) = w;
            }
    }
};

template <bool WITH_BF16> struct EpiResid {
    static constexpr bool PERM = false, AFTER_DRAIN = false;
    const float* base; float* out; bf16_t* ob; float alpha; float* ss;
    __device__ __forceinline__ void operator()(const f32x4 (&acc)[2][2][4][2], const Unit& u, int wr, int wc, int fr, int fq) const {
        typedef unsigned u32x2v __attribute__((ext_vector_type(2)));
        const int row0 = u.pm * BM + wr * 64 + fr, col0 = u.pn * BM + wc * 32 + 4 * fq;
#pragma unroll
        for (int ai = 0; ai < 2; ++ai)
#pragma unroll
            for (int m = 0; m < 4; ++m) {
                const int row = row0 + ai * HALF + m * 16; const size_t off = (size_t)row * 1024 + col0; float sq = 0.f;
#pragma unroll
                for (int bj = 0; bj < 2; ++bj)
#pragma unroll
                    for (int n = 0; n < 2; ++n) {
                        const f32x4 b = *(const f32x4*)(base + off + bj * HALF + n * 16);
                        const f32x4 o = b + acc[ai][bj][m][n] * alpha;
                        *(f32x4*)(out + off + bj * HALF + n * 16) = o;
                        sq += (o[0] * o[0] + o[1] * o[1]) + (o[2] * o[2] + o[3] * o[3]);
                        if (WITH_BF16) { u32x2v w; w.x = cvtpk_m(o[0], o[1]); w.y = cvtpk_m(o[2], o[3]); *(u32x2v*)(ob + off + bj * HALF + n * 16) = w; }
                    }
                sq += __shfl_xor(sq, 16); sq += __shfl_xor(sq, 32);
                if (fq == 0) (void)__hip_atomic_fetch_add(ss + row, sq, __ATOMIC_RELAXED, __HIP_MEMORY_SCOPE_AGENT);
                asm volatile("" ::: "memory");
            }
    }
};

struct EpiUProj {
    static constexpr bool PERM = true, AFTER_DRAIN = false;
    bf16_t* U; const float* ss; const float* cosT; const float* sinT;
    __device__ __forceinline__ void operator()(const f32x4 (&acc)[2][2][4][2], const Unit& u, int wr, int wc, int fr, int fq) const {
        const int row0 = u.pm * BM + wr * 64 + fr, col0 = u.pn * BM + wc * 32 + 8 * fq;
        const bool rot = u.pn < 4;
        const float sc = (u.pn == 2 || u.pn == 3) ? 0.08838834764831845f : ((u.pn == 8 || u.pn == 9) ? 0.125f : 1.0f);
#pragma unroll
        for (int ai = 0; ai < 2; ++ai)
#pragma unroll
            for (int m = 0; m < 4; ++m) {
                const int row = row0 + ai * HALF + m * 16; const float rs = row_rs(ss, row) * sc;
                f32x4 c4 = (f32x4){1.f, 1.f, 1.f, 1.f}, s4 = (f32x4){0.f, 0.f, 0.f, 0.f};
                if (rot) { const int pos = row & 8191; c4 = *(const f32x4*)(cosT + pos * 64 + 16 * wc + 4 * fq); s4 = *(const f32x4*)(sinT + pos * 64 + 16 * wc + 4 * fq); }
#pragma unroll
                for (int bj = 0; bj < 2; ++bj) {
                    const f32x4 v0 = acc[ai][bj][m][0] * rs, v1 = acc[ai][bj][m][1] * rs;
                    u32x4 w;
                    w.x = cvtpk_m(v0[0] * c4[0] - v0[1] * s4[0], v0[1] * c4[0] + v0[0] * s4[0]);
                    w.y = cvtpk_m(v0[2] * c4[1] - v0[3] * s4[1], v0[3] * c4[1] + v0[2] * s4[1]);
                    w.z = cvtpk_m(v1[0] * c4[2] - v1[1] * s4[2], v1[1] * c4[2] + v1[0] * s4[2]);
                    w.w = cvtpk_m(v1[2] * c4[3] - v1[3] * s4[3], v1[3] * c4[3] + v1[2] * s4[3]);
                    *(u32x4*)(U + (size_t)row * 3584 + col0 + bj * HALF) = w;
                }
            }
    }
};
template <class Epi, class Sched, bool ALIGN_EPI = false, bool SP2 = false>
__device__ __forceinline__ void gemm_phase(PG8_LAS unsigned char* lds, const Gemm g, const Sched& S, const Epi& E) {
    const int tid = threadIdx.x, wid = __builtin_amdgcn_readfirstlane(tid >> 6), lane = tid & 63, wr = wid >> 2, wc = wid & 3, fr = lane & 15, fq = lane >> 4;
    const int K = g.K, nt = K / BK;
    unsigned voffA[2], voffB[2];
#pragma unroll
    for (int i = 0; i < 2; ++i) { int R, C; stage_rc(tid * 16 + i * 8192, R, C); const int Rb = Epi::PERM ? ((R & ~31) + perm32(R & 31)) : R;
        voffA[i] = (unsigned)(R * K + C) * 2u; voffB[i] = (unsigned)(Rb * K + C) * 2u; }
    const size_t kstep = (size_t)(BK * 2);
    const size_t hstep = (size_t)HALF * K * 2;
    const size_t tstep = 2 * hstep;
    const unsigned ldsw = (unsigned)wid * 1024u;
    const int aoff = lds_byte(wr * 64 + fr, fq * 8), boff = lds_byte(wc * 32 + fr, fq * 8);
#define PG8_SA(b, h) (((b) * 2 + (h)) * HTB)
#define PG8_SB(b, h) ((4 + (b) * 2 + (h)) * HTB)
#define PG8_STAGE(bufoff, gbase, voff) do { _Pragma("unroll") for (int _i = 0; _i < 2; ++_i) \
        __builtin_amdgcn_global_load_lds((const unsigned*)((const char*)(gbase) + (voff)[_i]), (PG8_LAS unsigned*)(lds + (bufoff) + ldsw + _i * 8192), 16, 0, 0); } while (0)
#define PG8_LDA(dst, b, h) do { _Pragma("unroll") for (int m = 0; m < 4; ++m) _Pragma("unroll") for (int k = 0; k < 2; ++k) dst[m][k] = *(const PG8_LAS bf16x8*)(lds + PG8_SA(b, h) + aoff + m * 2048 + k * 1024); } while (0)
#define PG8_LDB(dst, b, h) do { _Pragma("unroll") for (int n = 0; n < 2; ++n) _Pragma("unroll") for (int k = 0; k < 2; ++k) dst[n][k] = *(const PG8_LAS bf16x8*)(lds + PG8_SB(b, h) + boff + n * 2048 + k * 1024); } while (0)
#define PG8_MMA(ai, bj, At, Bt) do { __builtin_amdgcn_s_setprio(1); _Pragma("unroll") for (int m = 0; m < 4; ++m) _Pragma("unroll") for (int n = 0; n < 2; ++n) _Pragma("unroll") for (int k = 0; k < 2; ++k) \
        acc[ai][bj][m][n] = __builtin_amdgcn_mfma_f32_16x16x32_bf16(Bt[n][k], At[m][k], acc[ai][bj][m][n], 0, 0, 0); __builtin_amdgcn_s_setprio(0); } while (0)
#define PG8_WAIT_V(n) asm volatile("s_waitcnt vmcnt(" #n ")" ::: "memory")
#define PG8_WAIT_L(n) asm volatile("s_waitcnt lgkmcnt(" #n ")" ::: "memory")
#define PG8_BAR __builtin_amdgcn_s_barrier()
#define PG8_SCHED __builtin_amdgcn_sched_barrier(0)
    Unit cur, nxt; int ui = 0;
    if (!S.next(0, cur)) return;
    f32x4 acc[2][2][4][2];
#pragma unroll
    for (int a = 0; a < 2; ++a)
#pragma unroll
        for (int b = 0; b < 2; ++b)
#pragma unroll
            for (int m = 0; m < 4; ++m)
#pragma unroll
                for (int n = 0; n < 2; ++n) acc[a][b][m][n] = (f32x4){0.f, 0.f, 0.f, 0.f};
    bf16x8 At[4][2], B0[2][2], B1[2][2];
    const char* cA = (const char*)g.A + (size_t)cur.pm * tstep; const char* cB = (const char*)g.Bt + (size_t)cur.pn * tstep;
    S.a_ready(cur);
    if constexpr (SP2) {
        PG8_STAGE(PG8_SB(0, 0), cB, voffB); PG8_STAGE(PG8_SB(0, 1), cB + hstep, voffB); PG8_STAGE(PG8_SA(0, 0), cA, voffA); PG8_STAGE(PG8_SA(0, 1), cA + hstep, voffA);
        if (wr == 1) PG8_BAR;
        PG8_WAIT_V(2); PG8_BAR;
        PG8_STAGE(PG8_SB(1, 0), cB + kstep, voffB); PG8_STAGE(PG8_SA(1, 0), cA + kstep, voffA); PG8_STAGE(PG8_SB(1, 1), cB + hstep + kstep, voffB);
        PG8_WAIT_V(6); PG8_BAR;
    } else {
        PG8_STAGE(PG8_SB(0, 0), cB, voffB); PG8_STAGE(PG8_SA(0, 0), cA, voffA); PG8_STAGE(PG8_SB(0, 1), cB + hstep, voffB); PG8_STAGE(PG8_SA(0, 1), cA + hstep, voffA);
        if (wr == 1) PG8_BAR;
        PG8_WAIT_V(4); PG8_BAR;
        PG8_STAGE(PG8_SB(1, 0), cB + kstep, voffB); PG8_STAGE(PG8_SA(1, 0), cA + kstep, voffA); PG8_STAGE(PG8_SB(1, 1), cB + hstep + kstep, voffB);
        PG8_WAIT_V(6); PG8_BAR;
    }
    for (;;) {
        const bool has_next = S.next(ui + 1, nxt);
        const char* nA = has_next ? (const char*)g.A + (size_t)nxt.pm * tstep : cA; const char* nB = has_next ? (const char*)g.Bt + (size_t)nxt.pn * tstep : cB;
        for (int t = 0; t < nt; t += 2) {
            const bool last = (t == nt - 2);
            const char* a1 = cA + (size_t)(t + 1) * kstep;
            const char* a2 = last ? nA : cA + (size_t)(t + 2) * kstep; const char* b2 = last ? nB : cB + (size_t)(t + 2) * kstep;
            const char* a3 = a2 + kstep; const char* b3 = b2 + kstep;
            if (last && has_next) S.a_ready(nxt);
            if constexpr (SP2) {
            PG8_LDB(B0, 0, 0); PG8_LDB(B1, 0, 1); PG8_SCHED; PG8_LDA(At, 0, 0); PG8_STAGE(PG8_SA(1, 1), a1 + hstep, voffA);
            PG8_WAIT_V(8); PG8_WAIT_L(0); PG8_BAR; PG8_MMA(0, 0, At, B0); PG8_MMA(0, 1, At, B1); PG8_BAR; PG8_SCHED;
            PG8_LDA(At, 0, 1); PG8_STAGE(PG8_SB(0, 0), b2, voffB); PG8_STAGE(PG8_SB(0, 1), b2 + hstep, voffB); PG8_STAGE(PG8_SA(0, 0), a2, voffA);
            PG8_WAIT_V(8); PG8_WAIT_L(0); PG8_BAR; PG8_MMA(1, 0, At, B0); PG8_MMA(1, 1, At, B1); PG8_BAR; PG8_SCHED;
            PG8_LDB(B0, 1, 0); PG8_LDB(B1, 1, 1); PG8_SCHED; PG8_LDA(At, 1, 0); PG8_STAGE(PG8_SA(0, 1), a2 + hstep, voffA);
            PG8_WAIT_V(8); PG8_WAIT_L(0); PG8_BAR; PG8_MMA(0, 0, At, B0); PG8_MMA(0, 1, At, B1); PG8_BAR; PG8_SCHED;
            PG8_LDA(At, 1, 1); PG8_STAGE(PG8_SB(1, 0), b3, voffB); PG8_STAGE(PG8_SB(1, 1), b3 + hstep, voffB); PG8_STAGE(PG8_SA(1, 0), a3, voffA);
            PG8_WAIT_V(8); PG8_WAIT_L(0); PG8_BAR; PG8_MMA(1, 0, At, B0); PG8_MMA(1, 1, At, B1); PG8_BAR; PG8_SCHED;
            } else {
            PG8_LDB(B0, 0, 0); PG8_SCHED; PG8_LDA(At, 0, 0); PG8_STAGE(PG8_SA(1, 1), a1 + hstep, voffA);
            PG8_WAIT_L(8); PG8_BAR; PG8_WAIT_L(0); PG8_MMA(0, 0, At, B0); PG8_BAR; PG8_SCHED;
            PG8_LDB(B1, 0, 1); PG8_STAGE(PG8_SB(0, 0), b2, voffB);
            PG8_BAR; PG8_WAIT_L(0); PG8_MMA(0, 1, At, B1); PG8_BAR;
            PG8_LDA(At, 0, 1); PG8_STAGE(PG8_SA(0, 0), a2, voffA);
            PG8_BAR; PG8_WAIT_L(0); PG8_MMA(1, 0, At, B0); PG8_BAR; PG8_SCHED;
            PG8_STAGE(PG8_SB(0, 1), b2 + hstep, voffB);
            PG8_WAIT_V(6); PG8_BAR; PG8_MMA(1, 1, At, B1); PG8_BAR;
            PG8_LDB(B0, 1, 0); PG8_SCHED; PG8_LDA(At, 1, 0); PG8_STAGE(PG8_SA(0, 1), a2 + hstep, voffA);
            PG8_WAIT_L(8); PG8_BAR; PG8_WAIT_L(0); PG8_MMA(0, 0, At, B0); PG8_BAR; PG8_SCHED;
            PG8_LDB(B1, 1, 1); PG8_STAGE(PG8_SB(1, 0), b3, voffB);
            PG8_BAR; PG8_WAIT_L(0); PG8_MMA(0, 1, At, B1); PG8_BAR;
            PG8_LDA(At, 1, 1); PG8_STAGE(PG8_SA(1, 0), a3, voffA);
            PG8_BAR; PG8_WAIT_L(0); PG8_MMA(1, 0, At, B0); PG8_BAR; PG8_SCHED;
            PG8_STAGE(PG8_SB(1, 1), b3 + hstep, voffB);
            PG8_WAIT_V(6); PG8_BAR; PG8_MMA(1, 1, At, B1); PG8_BAR;
            }
        }
        if constexpr (ALIGN_EPI) { if (wr == 0) PG8_BAR; }
        if constexpr (!Epi::AFTER_DRAIN) { E(acc, cur, wr, wc, fr, fq); S.done(cur); }
        if (!has_next) break;
#pragma unroll
        for (int a = 0; a < 2; ++a)
#pragma unroll
            for (int b = 0; b < 2; ++b)
#pragma unroll
                for (int m = 0; m < 4; ++m)
#pragma unroll
                    for (int n = 0; n < 2; ++n) acc[a][b][m][n] = (f32x4){0.f, 0.f, 0.f, 0.f};
        cur = nxt; cA = nA; cB = nB; ++ui;
        if constexpr (ALIGN_EPI) { if (wr == 1) PG8_BAR; }
    }
    PG8_WAIT_V(0);
    if constexpr (!ALIGN_EPI) { if (wr == 0) PG8_BAR; }
    PG8_BAR;
    if constexpr (Epi::AFTER_DRAIN) { E.fused(acc, cur, wr, wc, fr, fq, lds, wid, lane); S.done(cur); }
#undef PG8_SA
#undef PG8_SB
#undef PG8_STAGE
#undef PG8_LDA
#undef PG8_LDB
#undef PG8_MMA
#undef PG8_WAIT_V
#undef PG8_WAIT_L
#undef PG8_BAR
#undef PG8_SCHED
}
}
constexpr int NWAVES = 8;
constexpr int BATCH = 4, SEQ = 8192, D = 1024, FF = 2816, NIN = 3584;
constexpr int M = BATCH * SEQ;
constexpr float NORM_EPS = 1e-6f;
constexpr size_t MiB = 1u << 20;
constexpr size_t WS_CTL = 0, CTL_ZERO_BYTES = 1 * MiB;
constexpr size_t WS_SS1 = 256 * 1024, WS_SS2 = 384 * 1024, WS_SS3 = 512 * 1024;
constexpr size_t WS_SS0 = 1 * MiB;
constexpr size_t WS_COS = 2 * MiB, WS_SIN = 4 * MiB;
constexpr size_t WS_WGU1 = 6 * MiB, WS_WD1 = 17 * MiB, WS_WIN = 23 * MiB, WS_WOUT = 30 * MiB, WS_WGU2 = 32 * MiB, WS_WD2 = 43 * MiB;
constexpr size_t WS_XB = 50 * MiB;
constexpr size_t WS_UA = 114 * MiB;
constexpr size_t WS_MIX = 338 * MiB;
constexpr size_t WS_ATT = 402 * MiB;
constexpr size_t WS_END = 502 * MiB;
static_assert(WS_WD2 + (size_t)D * FF * 2 <= WS_XB && WS_XB + (size_t)M * D * 2 <= WS_UA && WS_UA + (size_t)M * NIN * 2 <= WS_MIX && WS_MIX + (size_t)M * D * 2 <= WS_ATT, "d_ws map");
constexpr int CW_TMO = 0, CW_CODE = 1;
constexpr int CW_BAR = 4096;
constexpr int RING_OFF = 0, RING_BYTES = 131072;
constexpr int LDSCTL_OFF = RING_BYTES, MISC_OFF = LDSCTL_OFF + 320;
constexpr int LDS_BYTES = 147456;
constexpr int N_PHASES = 9;
struct Args { const float* in[14]; float* out; unsigned char* ws; int ph_lo, ph_hi, li, pad; };
#define GAS __attribute__((address_space(1)))
#define LAS __attribute__((address_space(3)))
typedef unsigned short bf16;
typedef unsigned v4u __attribute__((ext_vector_type(4)));
typedef float f32x4 __attribute__((ext_vector_type(4)));
typedef short bf16x8 __attribute__((ext_vector_type(8)));
typedef GAS unsigned gu32;
typedef GAS unsigned long long gu64;
#define RLX_AGENT __ATOMIC_RELAXED, __HIP_MEMORY_SCOPE_AGENT
#define LDS_WAIT() asm volatile("s_waitcnt lgkmcnt(0)" ::: "memory")
#define VM_WAIT() asm volatile("s_waitcnt vmcnt(0)" ::: "memory")
__device__ __forceinline__ unsigned long long rt() { return __builtin_amdgcn_s_memrealtime(); }
__device__ __forceinline__ unsigned f2bf(float f) { unsigned u = __builtin_bit_cast(unsigned, f); return (u + 0x7fffu + ((u >> 16) & 1u)) >> 16; }
__device__ __forceinline__ unsigned pk2(float lo, float hi) { return f2bf(lo) | (f2bf(hi) << 16); }

#define XB_TMO      128
#define XB_XCNT(j)  (256  + 64 * (j))
#define XB_XSUB(j)  (1280 + 64 * (j))
#define XB_XGEN(j)  (2304 + 64 * (j))
#define XB_TOP      3328
#define XB_TOPGEN   3392
#define XCD_BAR_WORDS 3456
#define XB_SPIN_CAP (1u << 18)

__device__ __forceinline__ unsigned xb_ld(unsigned* p)              { return __hip_atomic_load(p, __ATOMIC_RELAXED, __HIP_MEMORY_SCOPE_AGENT); }
__device__ __forceinline__ unsigned xb_add(unsigned* p, unsigned v) { return __hip_atomic_fetch_add(p, v, __ATOMIC_RELAXED, __HIP_MEMORY_SCOPE_AGENT); }
__device__ __forceinline__ unsigned xb_xcc_id() { return (unsigned)__builtin_amdgcn_s_getreg((3 << 11) | 20) & 0xFu; }
#define XB_SPIN(cond, bar) do { unsigned _sp = 0; while (cond) { __builtin_amdgcn_s_sleep(1); \
    if ((++_sp & 255u) == 0u) { if (xb_ld(&(bar)[XB_TMO])) break; if (_sp > XB_SPIN_CAP) { atomicAdd(&(bar)[XB_TMO], 1u); break; } } } } while (0)

struct XcdBarrier {
    unsigned* bar; unsigned x;
    volatile LAS unsigned* st;
};

__device__ __forceinline__ XcdBarrier xcd_barrier_post(unsigned* bar, volatile LAS unsigned* st) {
    XcdBarrier b; b.bar = bar; b.x = xb_xcc_id(); b.st = st;
    if (threadIdx.x == 0) (void)xb_add(&bar[XB_XCNT(b.x)], 1u);
    return b;
}
__device__ __forceinline__ void xcd_barrier_complete(unsigned* bar, unsigned x, unsigned& nloc, unsigned& nx) {
    const unsigned G = gridDim.x * gridDim.y * gridDim.z;
    unsigned sum, cnt, mine, sp = 0u;
    for (;;) {
        sum = 0u; cnt = 0u; mine = 0u;
#pragma unroll
        for (unsigned j = 0; j < 16; ++j) { const unsigned c = xb_ld(&bar[XB_XCNT(j)]); sum += c; cnt += (c > 0u) ? 1u : 0u; mine = (j == x) ? c : mine; }
        if (sum == G) break;
        __builtin_amdgcn_s_sleep(1);
        if ((++sp & 255u) == 0u) { if (xb_ld(&bar[XB_TMO])) break; if (sp > XB_SPIN_CAP) { atomicAdd(&bar[XB_TMO], 1u); break; } }
    }
    nloc = mine > 0u ? mine : 1u; nx = cnt > 0u ? cnt : 1u;
}

__device__ __forceinline__ void xcd_barrier(const XcdBarrier& b) {
    asm volatile("s_waitcnt vmcnt(0)" ::: "memory");
    __syncthreads();
    if (threadIdx.x == 0) {
        unsigned* bar = b.bar;
        __builtin_amdgcn_s_waitcnt(0);
        unsigned nloc = b.st[0], nx = b.st[1];
        if (nloc == 0u) { xcd_barrier_complete(bar, b.x, nloc, nx); b.st[0] = nloc; b.st[1] = nx; }
        const unsigned old = xb_add(&bar[XB_XSUB(b.x)], 1u);
        const unsigned gen = old / nloc;
        if (old + 1u == (gen + 1u) * nloc) {
            __builtin_amdgcn_fence(__ATOMIC_RELEASE, "agent");
            asm volatile("s_waitcnt vmcnt(0)" ::: "memory");
            const unsigned og = xb_add(&bar[XB_TOP], 1u);
            const unsigned tg = og / nx;
            if (og + 1u == (tg + 1u) * nx) xb_add(&bar[XB_TOPGEN], 1u);
            else XB_SPIN(xb_ld(&bar[XB_TOPGEN]) == tg, bar);
            __builtin_amdgcn_fence(__ATOMIC_ACQUIRE, "agent");
            xb_add(&bar[XB_XGEN(b.x)], 1u);
            asm volatile("s_waitcnt vmcnt(0)" ::: "memory");
        } else {
            XB_SPIN(xb_ld(&bar[XB_XGEN(b.x)]) == gen, bar);
            __builtin_amdgcn_fence(__ATOMIC_ACQUIRE, "agent");
            asm volatile("s_waitcnt vmcnt(0)" ::: "memory");
        }
    }
    __syncthreads();
}
struct Frame {
    LAS unsigned char* lds;
    volatile LAS unsigned* MISC;
    gu32* ctl;
    int tid, lane, wave;
    int vcu, G;
};
__device__ __forceinline__ float wave_sum(float v) {
#pragma unroll
    for (int o = 1; o < 64; o <<= 1) v += __shfl_xor(v, o);
    return v;
}
__device__ __forceinline__ float bf2f(unsigned short b) { return __uint_as_float((unsigned)b << 16); }

typedef short v4i16_t __attribute__((ext_vector_type(4)));
typedef short s16x4 __attribute__((ext_vector_type(4)));
constexpr float LOG2E = 1.4426950408889634f, LN2 = 0.6931471805599453f;
constexpr int AP = 160;
constexpr int A_K = 0, A_V = 256 * AP;
constexpr int RP = 288;
constexpr int R_K = 0, R_V = 128 * RP, R_S = 256 * RP, R_G = 384 * RP;
static_assert(A_V + 256 * AP <= RING_BYTES && R_G + 512 <= RING_BYTES, "mixer LDS");
constexpr size_t WS_KV = WS_XB;
constexpr size_t WS_OP = WS_ATT, WS_LSE = WS_ATT + 96 * MiB;
static_assert(WS_LSE + 3 * (size_t)M * 8 * 4 <= WS_END, "mixer ws");

__device__ __forceinline__ s16x4 tr_read4(LAS unsigned char* p) { return __builtin_bit_cast(s16x4, __builtin_amdgcn_ds_read_tr16_b64_v4i16((LAS v4i16_t*)p)); }
__device__ __forceinline__ bf16x8 tr_frag(LAS unsigned char* p0, LAS unsigned char* p1) { const s16x4 a = tr_read4(p0), b = tr_read4(p1); return (bf16x8){a[0], a[1], a[2], a[3], b[0], b[1], b[2], b[3]}; }
__device__ __forceinline__ bf16x8 pack8(const f32x4& a, const f32x4& b) {
    v4u w; w.x = pg8::cvtpk_m(a[0], a[1]); w.y = pg8::cvtpk_m(a[2], a[3]); w.z = pg8::cvtpk_m(b[0], b[1]); w.w = pg8::cvtpk_m(b[2], b[3]); return __builtin_bit_cast(bf16x8, w); }
#define LDS_BAR() do { asm volatile("s_waitcnt lgkmcnt(0)" ::: "memory"); __builtin_amdgcn_s_barrier(); asm volatile("" ::: "memory"); } while (0)
#define MFMA16(a, b, c) __builtin_amdgcn_mfma_f32_16x16x32_bf16((a), (b), (c), 0, 0, 0)

struct AttnU { int p, g, n, dil, b, h; };
__device__ __forceinline__ AttnU attn_decode(int unit) {
    AttnU a; const int bh = unit / 192; int r = unit % 192;
    if (r < 64) { a.p = 0; a.dil = 1; a.g = 0; a.n = r; } else if (r < 128) { r -= 64; a.p = 1; a.dil = 4; a.g = r >> 4; a.n = r & 15; } else { r -= 128; a.p = 2; a.dil = 16; a.g = r >> 2; a.n = r & 3; }
    a.b = bh >> 3; a.h = bh & 7; return a;
}
__device__ __forceinline__ void attn_units(Frame& F, const bf16* U, bf16* OP, float* LSE, int u0, int u1) {
    if (u0 >= u1) return;
    const int lane = F.lane, w = F.wave, g4 = lane >> 4, l15 = lane & 15, qq = l15 >> 2, pp = lane & 3;
    const int kb0 = 32 * (w >> 1), qi = 16 * w + l15;
    v4u pk[4], pv[4]; bf16x8 pq[2];
#define ATTN_ISSUE(unit) do { const AttnU a_ = attn_decode(unit); const bf16* Ub_ = U + (size_t)a_.b * SEQ * NIN; \
        _Pragma("unroll") for (int i = 0; i < 4; ++i) { const int kj_ = (F.tid >> 3) + 64 * i, c16_ = F.tid & 7; int tk_ = a_.g + a_.dil * (128 * (a_.n - 1) + kj_); tk_ = tk_ < 0 ? 0 : tk_; \
            pk[i] = *(const GAS v4u*)(Ub_ + (size_t)tk_ * NIN + 2560 + a_.h * 64 + c16_ * 8); pv[i] = *(const GAS v4u*)(Ub_ + (size_t)tk_ * NIN + 3072 + a_.h * 64 + c16_ * 8); } \
        const int tq_ = a_.g + a_.dil * (128 * a_.n + qi); \
        _Pragma("unroll") for (int ks = 0; ks < 2; ++ks) pq[ks] = *(const GAS bf16x8*)(Ub_ + (size_t)tq_ * NIN + 2048 + a_.h * 64 + 32 * ks + 8 * g4); } while (0)
    ATTN_ISSUE(u0);
    for (int unit = u0; unit < u1; ++unit) {
        const AttnU a = attn_decode(unit);
#pragma unroll
        for (int i = 0; i < 4; ++i) { const int kj = (F.tid >> 3) + 64 * i, c16 = F.tid & 7; const bool dead = (a.n == 0) && (i < 2);
            *(LAS v4u*)(F.lds + A_K + kj * AP + c16 * 16) = dead ? (v4u){0u, 0u, 0u, 0u} : pk[i]; *(LAS v4u*)(F.lds + A_V + kj * AP + c16 * 16) = dead ? (v4u){0u, 0u, 0u, 0u} : pv[i]; }
        const bf16x8 qf0 = pq[0], qf1 = pq[1];
        LDS_BAR();
        if (unit + 1 < u1) ATTN_ISSUE(unit + 1);
        f32x4 s[10];
        {
            bf16x8 ka[10][2];
#pragma unroll
            for (int kt = 0; kt < 10; ++kt)
#pragma unroll
                for (int ks = 0; ks < 2; ++ks) ka[kt][ks] = *(const LAS bf16x8*)(F.lds + A_K + (kb0 + 16 * kt + l15) * AP + (32 * ks + 8 * g4) * 2);
            __builtin_amdgcn_sched_barrier(0);
#pragma unroll
            for (int kt = 0; kt < 10; ++kt) { s[kt] = MFMA16(ka[kt][0], qf0, ((f32x4){0.f, 0.f, 0.f, 0.f})); s[kt] = MFMA16(ka[kt][1], qf1, s[kt]); }
        }
        bf16x8 va[4][5];
#pragma unroll
        for (int dt = 0; dt < 4; ++dt)
#pragma unroll
            for (int kk = 0; kk < 5; ++kk) { LAS unsigned char* vp = F.lds + A_V + (kb0 + 32 * kk + 4 * g4 + qq) * AP + (16 * dt + 4 * pp) * 2; va[dt][kk] = tr_frag(vp, vp + 16 * AP); }
        __builtin_amdgcn_sched_barrier(0);
        float mx = -INFINITY;
#pragma unroll
        for (int kt = 0; kt < 10; ++kt) {
            if (kt < 2 || kt >= 8 || a.n == 0) {
#pragma unroll
                for (int rr = 0; rr < 4; ++rr) { const int kj = kb0 + 16 * kt + 4 * g4 + rr; const bool ok = (kj >= qi) && (kj <= qi + 128) && (128 * (a.n - 1) + kj >= 0);
                    const float v = ok ? s[kt][rr] * LOG2E : -INFINITY; s[kt][rr] = v; mx = fmaxf(mx, v); }
            } else {
#pragma unroll
                for (int rr = 0; rr < 4; ++rr) { const float v = s[kt][rr] * LOG2E; s[kt][rr] = v; mx = fmaxf(mx, v); }
            }
        }
        mx = fmaxf(mx, __shfl_xor(mx, 16)); mx = fmaxf(mx, __shfl_xor(mx, 32));
        float lsum = 0.f;
#pragma unroll
        for (int kt = 0; kt < 10; ++kt)
#pragma unroll
            for (int rr = 0; rr < 4; ++rr) { const float e = __builtin_amdgcn_exp2f(s[kt][rr] - mx); s[kt][rr] = e; lsum += e; }
        lsum += __shfl_xor(lsum, 16); lsum += __shfl_xor(lsum, 32);
        bf16x8 pb[5];
#pragma unroll
        for (int kk = 0; kk < 5; ++kk) pb[kk] = pack8(s[2 * kk], s[2 * kk + 1]);
        f32x4 o[4];
#pragma unroll
        for (int dt = 0; dt < 4; ++dt) { o[dt] = (f32x4){0.f, 0.f, 0.f, 0.f};
#pragma unroll
            for (int kk = 0; kk < 5; ++kk) o[dt] = MFMA16(va[dt][kk], pb[kk], o[dt]); }
        const float inv = 1.0f / lsum; const int tq = a.g + a.dil * (128 * a.n + qi); const size_t tok = (size_t)a.b * SEQ + tq;
        bf16* op = OP + ((size_t)a.p * M + tok) * 512 + a.h * 64 + 4 * g4;
#pragma unroll
        for (int dt = 0; dt < 4; ++dt) { const f32x4 v = o[dt] * inv; unsigned long long wv = (unsigned long long)pg8::cvtpk_m(v[0], v[1]) | ((unsigned long long)pg8::cvtpk_m(v[2], v[3]) << 32);
            *(GAS unsigned long long*)(op + 16 * dt) = wv; }
        if (g4 == 0) LSE[((size_t)a.p * M + tok) * 8 + a.h] = mx * LN2 + __logf(lsum);
        LDS_BAR();
    }
#undef ATTN_ISSUE
}

__device__ __forceinline__ void attn_combine(Frame& F, const bf16* OP, const float* LSE, bf16* MIX) {
    const int gw = F.vcu * NWAVES + F.wave, NGW = F.G * NWAVES; const int h = F.lane >> 3;
    for (int t = gw; t < M; t += NGW) {
        float l0 = LSE[((size_t)0 * M + t) * 8 + h], l1 = LSE[((size_t)1 * M + t) * 8 + h], l2 = LSE[((size_t)2 * M + t) * 8 + h];
        const float mx = fmaxf(l0, fmaxf(l1, l2));
        float w0 = __expf(l0 - mx), w1 = __expf(l1 - mx), w2 = __expf(l2 - mx); const float inv = 1.0f / (w0 + w1 + w2); w0 *= inv; w1 *= inv; w2 *= inv;
        const v4u a = *(const GAS v4u*)(OP + ((size_t)0 * M + t) * 512 + F.lane * 8), bq = *(const GAS v4u*)(OP + ((size_t)1 * M + t) * 512 + F.lane * 8), c = *(const GAS v4u*)(OP + ((size_t)2 * M + t) * 512 + F.lane * 8);
        v4u o;
#pragma unroll
        for (int j = 0; j < 4; ++j) { const unsigned x = a[j], y = bq[j], z = c[j];
            const float lo = w0 * __uint_as_float(x << 16) + w1 * __uint_as_float(y << 16) + w2 * __uint_as_float(z << 16);
            const float hi = w0 * __uint_as_float(x & 0xffff0000u) + w1 * __uint_as_float(y & 0xffff0000u) + w2 * __uint_as_float(z & 0xffff0000u);
            o[j] = pg8::cvtpk_m(lo, hi); }
        *(GAS v4u*)(MIX + (size_t)t * D + 512 + F.lane * 8) = o;
    }
}

__device__ __forceinline__ void kv_units(Frame& F, const bf16* U, bf16* KV, int u0, int u1) {
    if (u0 >= u1) return;
    const int lane = F.lane, w = F.wave, g4 = lane >> 4, l15 = lane & 15, qq = l15 >> 2, pp = lane & 3;
    v4u pk[4], pv[4];
#define KV_ISSUE(unit) do { const int bh_ = (unit) >> 6, n_ = (unit) & 63, b_ = bh_ >> 2, h_ = bh_ & 3; const size_t t0_ = (size_t)b_ * SEQ + 128 * n_; \
        _Pragma("unroll") for (int i = 0; i < 4; ++i) { const int m_ = (F.tid >> 4) + 32 * i, c16_ = F.tid & 15; \
            pk[i] = *(const GAS v4u*)(U + (t0_ + m_) * NIN + 512 + h_ * 128 + c16_ * 8); pv[i] = *(const GAS v4u*)(U + (t0_ + m_) * NIN + 1024 + h_ * 128 + c16_ * 8); } } while (0)
    KV_ISSUE(u0);
    for (int unit = u0; unit < u1; ++unit) {
        const int h = (unit >> 6) & 3;
        const float log2g = __log2f(1.0f - exp2f(-5.0f - (float)h));
#pragma unroll
        for (int i = 0; i < 4; ++i) { const int m = (F.tid >> 4) + 32 * i, c16 = F.tid & 15;
            const float z = __builtin_amdgcn_exp2f((float)(127 - m) * log2g);
            v4u kz;
#pragma unroll
            for (int j = 0; j < 4; ++j) kz[j] = pg8::cvtpk_m(__uint_as_float(pk[i][j] << 16) * z, __uint_as_float(pk[i][j] & 0xffff0000u) * z);
            *(LAS v4u*)(F.lds + R_K + m * RP + c16 * 16) = kz; *(LAS v4u*)(F.lds + R_V + m * RP + c16 * 16) = pv[i]; }
        LDS_BAR();
        if (unit + 1 < u1) KV_ISSUE(unit + 1);
        bf16x8 af[4];
#pragma unroll
        for (int ks = 0; ks < 4; ++ks) { LAS unsigned char* kp = F.lds + R_K + (32 * ks + 8 * g4 + qq) * RP + (16 * w + 4 * pp) * 2; af[ks] = tr_frag(kp, kp + 4 * RP); }
        bf16* out = KV + (size_t)unit * 16384;
#pragma unroll
        for (int hb = 0; hb < 2; ++hb) {
            bf16x8 vb[4][4];
#pragma unroll
            for (int et = 0; et < 4; ++et)
#pragma unroll
                for (int ks = 0; ks < 4; ++ks) { LAS unsigned char* vp = F.lds + R_V + (32 * ks + 8 * g4 + qq) * RP + (16 * (4 * hb + et) + 4 * pp) * 2; vb[et][ks] = tr_frag(vp, vp + 4 * RP); }
            __builtin_amdgcn_sched_barrier(0);
#pragma unroll
            for (int et = 0; et < 4; ++et) { f32x4 acc = (f32x4){0.f, 0.f, 0.f, 0.f};
#pragma unroll
                for (int ks = 0; ks < 4; ++ks) acc = MFMA16(af[ks], vb[et][ks], acc);
                const unsigned long long wv = (unsigned long long)pg8::cvtpk_m(acc[0], acc[1]) | ((unsigned long long)pg8::cvtpk_m(acc[2], acc[3]) << 32);
                *(GAS unsigned long long*)(out + (size_t)(16 * (4 * hb + et) + l15) * 128 + 16 * w + 4 * g4) = wv; }
            __builtin_amdgcn_sched_barrier(0);
        }
        LDS_BAR();
    }
#undef KV_ISSUE
}

__device__ __forceinline__ void scan_phase(Frame& F, bf16* KV) {
    const int gt = F.vcu * (NWAVES * 64) + F.tid, NGT = F.G * NWAVES * 64;
    for (int e = gt; e < 16 * 8192; e += NGT) {
        const int bh = e >> 13, pr = e & 8191, h = bh & 3;
        const float cd = exp2f(128.0f * __log2f(1.0f - exp2f(-5.0f - (float)h)));
        GAS unsigned* p = (GAS unsigned*)(KV + (size_t)bh * 64 * 16384) + pr;
        float s0 = 0.f, s1 = 0.f;
        for (int n0 = 0; n0 < 64; n0 += 16) {
            unsigned kvv[16];
#pragma unroll
            for (int j = 0; j < 16; ++j) kvv[j] = p[(size_t)(n0 + j) * 8192];
#pragma unroll
            for (int j = 0; j < 16; ++j) { p[(size_t)(n0 + j) * 8192] = pg8::cvtpk_m(s0, s1);
                s0 = s0 * cd + __uint_as_float(kvv[j] << 16); s1 = s1 * cd + __uint_as_float(kvv[j] & 0xffff0000u); }
        }
    }
}

__device__ __forceinline__ void ret_units(Frame& F, const bf16* U, const bf16* ST, const float* gain, bf16* MIX, int u0, int u1) {
    if (u0 >= u1) return;
    const int w = F.wave;
    int tv = F.tid; asm volatile("" : "+v"(tv));
    int c = 16 * w + (tv & 15);
    v4u pk[4], pv[4], ps[4]; bf16x8 pq[4];
#define RET_ISSUE(unit) do { const int bh_ = (unit) >> 6, n_ = (unit) & 63, b_ = bh_ >> 2, h_ = bh_ & 3; const size_t t0_ = (size_t)b_ * SEQ + 128 * n_; const bf16* st_ = ST + (size_t)(unit) * 16384; \
        _Pragma("unroll") for (int i = 0; i < 4; ++i) { const int m_ = (tv >> 4) + 32 * i, c16_ = tv & 15; \
            pk[i] = *(const GAS v4u*)(U + (t0_ + m_) * NIN + 512 + h_ * 128 + c16_ * 8); pv[i] = *(const GAS v4u*)(U + (t0_ + m_) * NIN + 1024 + h_ * 128 + c16_ * 8); ps[i] = *(const GAS v4u*)(st_ + m_ * 128 + c16_ * 8); } \
        } while (0)
#define RET_ISSUE_Q(unit) do { const int bh_ = (unit) >> 6, n_ = (unit) & 63, b_ = bh_ >> 2, h_ = bh_ & 3; const size_t t0_ = (size_t)b_ * SEQ + 128 * n_; \
        _Pragma("unroll") for (int ks = 0; ks < 4; ++ks) pq[ks] = *(const GAS bf16x8*)(U + (t0_ + c) * NIN + h_ * 128 + 32 * ks + 8 * ((tv >> 4) & 3)); } while (0)
    RET_ISSUE(u0); RET_ISSUE_Q(u0);
    for (int unit = u0; unit < u1; ++unit) {
        tv = F.tid; asm volatile("" : "+v"(tv));
        const int lane = tv & 63, g4 = lane >> 4, l15 = lane & 15, qq = l15 >> 2, pp = lane & 3; c = 16 * w + l15;
        const int bh = unit >> 6, n = unit & 63, b = bh >> 2, h = bh & 3; const size_t t0 = (size_t)b * SEQ + 128 * n; const size_t tq = t0 + c;
        const float log2g = __log2f(1.0f - exp2f(-5.0f - (float)h));
#pragma unroll
        for (int i = 0; i < 4; ++i) { const int m = (tv >> 4) + 32 * i, c16 = tv & 15;
            *(LAS v4u*)(F.lds + R_K + m * RP + c16 * 16) = pk[i]; *(LAS v4u*)(F.lds + R_V + m * RP + c16 * 16) = pv[i]; *(LAS v4u*)(F.lds + R_S + m * RP + c16 * 16) = ps[i]; }
        if (tv < 32) *(LAS f32x4*)(F.lds + R_G + tv * 16) = *(const GAS f32x4*)(gain + h * 128 + tv * 4);
        LDS_BAR();
        if (unit + 1 < u1) RET_ISSUE(unit + 1);
        f32x4 sa[8];
#pragma unroll
        for (int hb = 0; hb < 4; ++hb) {
            bf16x8 ka[2][4];
#pragma unroll
            for (int mt = 0; mt < 2; ++mt)
#pragma unroll
                for (int ks = 0; ks < 4; ++ks) ka[mt][ks] = *(const LAS bf16x8*)(F.lds + R_K + (16 * (2 * hb + mt) + l15) * RP + (32 * ks + 8 * g4) * 2);
            __builtin_amdgcn_sched_barrier(0);
#pragma unroll
            for (int mt = 0; mt < 2; ++mt) { f32x4 t = (f32x4){0.f, 0.f, 0.f, 0.f};
#pragma unroll
                for (int ks = 0; ks < 4; ++ks) t = MFMA16(ka[mt][ks], pq[ks], t);
                sa[2 * hb + mt] = t; }
        }
#pragma unroll
        for (int mt = 0; mt < 8; ++mt)
#pragma unroll
            for (int rr = 0; rr < 4; ++rr) { const int m = 16 * mt + 4 * g4 + rr; sa[mt][rr] = (m <= c) ? sa[mt][rr] * __builtin_amdgcn_exp2f((float)(c - m) * log2g) : 0.f; }
        bf16x8 pb[4];
#pragma unroll
        for (int kk = 0; kk < 4; ++kk) pb[kk] = pack8(sa[2 * kk], sa[2 * kk + 1]);
        bf16x8 qx[4];
        { const float xi = __builtin_amdgcn_exp2f((float)(c + 1) * log2g);
#pragma unroll
          for (int ks = 0; ks < 4; ++ks) { const v4u qw = __builtin_bit_cast(v4u, pq[ks]); v4u x;
#pragma unroll
            for (int j = 0; j < 4; ++j) x[j] = pg8::cvtpk_m(__uint_as_float(qw[j] << 16) * xi, __uint_as_float(qw[j] & 0xffff0000u) * xi);
            qx[ks] = __builtin_bit_cast(bf16x8, x); } }
        if (unit + 1 < u1) RET_ISSUE_Q(unit + 1);
        f32x4 acc[8];
#pragma unroll
        for (int et = 0; et < 8; ++et) {
            bf16x8 va[4], sf[4];
#pragma unroll
            for (int kk = 0; kk < 4; ++kk) { LAS unsigned char* vp = F.lds + R_V + (32 * kk + 4 * g4 + qq) * RP + (16 * et + 4 * pp) * 2; va[kk] = tr_frag(vp, vp + 16 * RP);
                sf[kk] = *(const LAS bf16x8*)(F.lds + R_S + (16 * et + l15) * RP + (32 * kk + 8 * g4) * 2); }
            __builtin_amdgcn_sched_barrier(0);
            f32x4 t = (f32x4){0.f, 0.f, 0.f, 0.f};
#pragma unroll
            for (int kk = 0; kk < 4; ++kk) t = MFMA16(va[kk], pb[kk], t);
#pragma unroll
            for (int ks = 0; ks < 4; ++ks) t = MFMA16(sf[ks], qx[ks], t);
            acc[et] = t;
        }
        unsigned long long rgw[8];
#pragma unroll
        for (int et = 0; et < 8; ++et) rgw[et] = *(const GAS unsigned long long*)(U + tq * NIN + 1536 + h * 128 + 16 * et + 4 * g4);
        float sum = 0.f;
#pragma unroll
        for (int et = 0; et < 8; ++et) sum += (acc[et][0] + acc[et][1]) + (acc[et][2] + acc[et][3]);
        sum += __shfl_xor(sum, 16); sum += __shfl_xor(sum, 32);
        const float mu = sum * (1.0f / 128.0f); float var = 0.f;
#pragma unroll
        for (int et = 0; et < 8; ++et) { acc[et] = acc[et] - mu; var += (acc[et][0] * acc[et][0] + acc[et][1] * acc[et][1]) + (acc[et][2] * acc[et][2] + acc[et][3] * acc[et][3]); }
        var += __shfl_xor(var, 16); var += __shfl_xor(var, 32);
        const float rstd = 1.0f / sqrtf(var * (1.0f / 128.0f) + 1e-6f);
#pragma unroll
        for (int et = 0; et < 8; ++et) { const int e = 16 * et + 4 * g4;
            const f32x4 gn = *(const LAS f32x4*)(F.lds + R_G + e * 4);
            const unsigned long long gw = rgw[et];
            const float r0 = __uint_as_float((unsigned)gw << 16), r1 = __uint_as_float((unsigned)gw & 0xffff0000u), r2 = __uint_as_float((unsigned)(gw >> 32) << 16), r3 = __uint_as_float((unsigned)(gw >> 32) & 0xffff0000u);
            const float o0 = acc[et][0] * rstd * gn[0] * pg8::silu_fast(r0), o1 = acc[et][1] * rstd * gn[1] * pg8::silu_fast(r1), o2 = acc[et][2] * rstd * gn[2] * pg8::silu_fast(r2), o3 = acc[et][3] * rstd * gn[3] * pg8::silu_fast(r3);
            *(GAS unsigned long long*)(MIX + tq * D + h * 128 + e) = (unsigned long long)pg8::cvtpk_m(o0, o1) | ((unsigned long long)pg8::cvtpk_m(o2, o3) << 32); }
        LDS_BAR();
    }
#undef RET_ISSUE
#undef RET_ISSUE_Q
}

__device__ __forceinline__ void mixer_phase(Frame& F, const Args& args, const XcdBarrier& bar) {
    unsigned char* ws = args.ws;
    const bf16* U = (const bf16*)(ws + WS_UA); bf16* KV = (bf16*)(ws + WS_KV); bf16* OP = (bf16*)(ws + WS_OP); float* LSE = (float*)(ws + WS_LSE); bf16* MIX = (bf16*)(ws + WS_MIX);
    { const int per = (1024 + F.G - 1) / F.G; const int ub = F.vcu * per, ue = (ub + per) < 1024 ? (ub + per) : 1024; kv_units(F, U, KV, ub, ue); }
    if (F.G % 8 == 0) {
        const int cpx = F.G / 8, xg = F.vcu / cpx, j = F.vcu % cpx, per = (192 + cpx - 1) / cpx;
        for (int r = 0; r < 4; ++r) { const int bh = r * 8 + xg; const int ub = j * per, ue = (ub + per) < 192 ? (ub + per) : 192; if (ub < ue) attn_units(F, U, OP, LSE, bh * 192 + ub, bh * 192 + ue); }
    } else { const int per = (6144 + F.G - 1) / F.G; const int ub = F.vcu * per, ue = (ub + per) < 6144 ? (ub + per) : 6144; attn_units(F, U, OP, LSE, ub, ue); }
#if DUP == 41
    if (F.G % 8 == 0) {
        const int cpx = F.G / 8, xg = F.vcu / cpx, j = F.vcu % cpx, per = (192 + cpx - 1) / cpx;
        for (int r = 0; r < 4; ++r) { const int bh = r * 8 + xg; const int ub = j * per, ue = (ub + per) < 192 ? (ub + per) : 192; if (ub < ue) attn_units(F, U, OP, LSE, bh * 192 + ub, bh * 192 + ue); }
    } else { const int per = (6144 + F.G - 1) / F.G; const int ub = F.vcu * per, ue = (ub + per) < 6144 ? (ub + per) : 6144; attn_units(F, U, OP, LSE, ub, ue); }
#endif
    xcd_barrier(bar);
    scan_phase(F, KV);
    xcd_barrier(bar);
    { const int per = (1024 + F.G - 1) / F.G; const int ub = F.vcu * per, ue = (ub + per) < 1024 ? (ub + per) : 1024; ret_units(F, U, KV, args.in[7], MIX, ub, ue); }
    attn_combine(F, OP, LSE, MIX);
#if DUP == 42
    { const int per = (1024 + F.G - 1) / F.G; const int ub = F.vcu * per, ue = (ub + per) < 1024 ? (ub + per) : 1024; ret_units(F, U, KV, args.in[7], MIX, ub, ue); }
#endif
#if DUP == 43
    attn_combine(F, OP, LSE, MIX);
#endif
}
__device__ __forceinline__ void p0_transpose_item(const float* W, int K, int N, bf16* WT, const float* gain, int mode, LAS float* scr, int item, int lane) {
    const int nblk = N / 32, kb = item / nblk, nb = item % nblk, k0 = 64 * kb, n0 = 32 * nb;
#pragma unroll 8
    for (int i = 0; i < 32; ++i) { const int kk = 2 * i + (lane >> 5); float w = W[(size_t)(k0 + kk) * N + n0 + (lane & 31)]; if (gain) w *= gain[k0 + kk]; scr[kk * 33 + (lane & 31)] = w; }
    LDS_WAIT(); asm volatile("" ::: "memory");
    const int c = lane & 7;
    const int drow0 = (mode == 0) ? n0 : ((n0 >> 7) * 256 + (n0 & 127) + (mode == 2 ? 128 : 0));
#pragma unroll
    for (int j = 0; j < 4; ++j) { const int n = (lane >> 3) + 8 * j; const LAS float* s = scr + (8 * c) * 33 + n;
        v4u o; o.x = pk2(s[0 * 33], s[1 * 33]); o.y = pk2(s[2 * 33], s[3 * 33]); o.z = pk2(s[4 * 33], s[5 * 33]); o.w = pk2(s[6 * 33], s[7 * 33]);
        *(GAS v4u*)(WT + (size_t)(drow0 + n) * K + k0 + 8 * c) = o; }
    LDS_WAIT(); asm volatile("" ::: "memory");
}


__device__ __forceinline__ void p0_prologue(Frame& F, const Args& args) {
    unsigned char* ws = args.ws;
    LAS float* scr = (LAS float*)(F.lds + RING_OFF + F.wave * 16384);
    const int gw = F.vcu * NWAVES + F.wave, NGW = F.G * NWAVES;
    constexpr int I_GU = (D / 64) * (FF / 32), I_DN = (FF / 64) * (D / 32), I_IN = (D / 64) * (NIN / 32), I_OUT = (D / 64) * (D / 32);
    constexpr int NITEMS = 4 * I_GU + 2 * I_DN + I_IN + I_OUT;
    for (int it = gw; it < NITEMS; it += NGW) {
        int r = it;
        if (r < I_GU) { p0_transpose_item(args.in[2], D, FF, (bf16*)(ws + WS_WGU1), args.in[1], 1, scr, r, F.lane); continue; } r -= I_GU;
        if (r < I_GU) { p0_transpose_item(args.in[3], D, FF, (bf16*)(ws + WS_WGU1), args.in[1], 2, scr, r, F.lane); continue; } r -= I_GU;
        if (r < I_DN) { p0_transpose_item(args.in[4], FF, D, (bf16*)(ws + WS_WD1), nullptr, 0, scr, r, F.lane); continue; } r -= I_DN;
        if (r < I_IN) { p0_transpose_item(args.in[6], D, NIN, (bf16*)(ws + WS_WIN), args.in[5], 0, scr, r, F.lane); continue; } r -= I_IN;
        if (r < I_OUT) { p0_transpose_item(args.in[8], D, D, (bf16*)(ws + WS_WOUT), nullptr, 0, scr, r, F.lane); continue; } r -= I_OUT;
        if (r < I_GU) { p0_transpose_item(args.in[10], D, FF, (bf16*)(ws + WS_WGU2), args.in[9], 1, scr, r, F.lane); continue; } r -= I_GU;
        if (r < I_GU) { p0_transpose_item(args.in[11], D, FF, (bf16*)(ws + WS_WGU2), args.in[9], 2, scr, r, F.lane); continue; } r -= I_GU;
        p0_transpose_item(args.in[12], FF, D, (bf16*)(ws + WS_WD2), nullptr, 0, scr, r, F.lane);
    }
    {
        const float* x = args.in[0]; bf16* xb = (bf16*)(ws + WS_XB); float* ss0 = (float*)(ws + WS_SS0);
        for (int m = gw; m < M; m += NGW) {
            const GAS f32x4* xr = (const GAS f32x4*)(x + (size_t)m * D) + F.lane;
            f32x4 v[4]; float s = 0.f;
#pragma unroll
            for (int j = 0; j < 4; ++j) { v[j] = xr[64 * j]; s += (v[j].x * v[j].x + v[j].y * v[j].y) + (v[j].z * v[j].z + v[j].w * v[j].w); }
            s = wave_sum(s);
            GAS unsigned long long* o8 = (GAS unsigned long long*)(xb + (size_t)m * D) + F.lane;
#pragma unroll
            for (int j = 0; j < 4; ++j) o8[64 * j] = (unsigned long long)pk2(v[j].x, v[j].y) | ((unsigned long long)pk2(v[j].z, v[j].w) << 32);
            if (F.lane == 0) ss0[m] = s;
        }
    }
    {
        float* cosT = (float*)(ws + WS_COS); float* sinT = (float*)(ws + WS_SIN);
        const int gt = F.vcu * (NWAVES * 64) + F.tid, NGT = F.G * NWAVES * 64;
        for (int e = gt; e < SEQ * 64; e += NGT) {
            const int s = e >> 6, i = e & 63;
            const float inv = powf(10000.0f, -(float)(2 * i) / 128.0f);
            const float ang = (float)s * inv;
            cosT[e] = cosf(ang); sinT[e] = sinf(ang);
        }
    }
}

__device__ __forceinline__ void p8_final(Frame& F, const Args& args) {
    const int gw = F.vcu * NWAVES + F.wave, NGW = F.G * NWAVES;
    const float* ss3 = (const float*)(args.ws + WS_SS3); const float* g = args.in[13];
    f32x4 gv[4];
#pragma unroll
    for (int j = 0; j < 4; ++j) gv[j] = ((const GAS f32x4*)g)[F.lane + 64 * j];
    for (int m = gw; m < M; m += NGW) {
        GAS f32x4* xr = (GAS f32x4*)(args.out + (size_t)m * D) + F.lane;
        const float rs = 1.0f / sqrtf(ss3[m] * (1.0f / 1024.0f) + NORM_EPS);
#pragma unroll
        for (int j = 0; j < 4; ++j) { f32x4 v = xr[64 * j]; v = v * rs * gv[j]; xr[64 * j] = v; }
    }
}

__global__ void __launch_bounds__(NWAVES * 64, 2) mk_fwd(Args args) {
    extern __shared__ __attribute__((aligned(16))) unsigned char lds[];
    Frame F;
    F.lds = (LAS unsigned char*)lds;
    F.MISC = (volatile LAS unsigned*)(F.lds + MISC_OFF);
    F.tid = threadIdx.x; F.lane = F.tid & 63; F.wave = __builtin_amdgcn_readfirstlane(F.tid >> 6);
    F.G = gridDim.x; { const int bx = blockIdx.x; F.vcu = (F.G % 8 == 0) ? (bx % 8) * (F.G / 8) + bx / 8 : bx; }
    unsigned char* ws = args.ws;
    F.ctl = (gu32*)(ws + WS_CTL);
    for (int u = F.tid; u < (LDS_BYTES - LDSCTL_OFF) / 4; u += NWAVES * 64) ((LAS unsigned*)(F.lds + LDSCTL_OFF))[u] = 0u;
    __syncthreads();
    XcdBarrier bar = xcd_barrier_post((unsigned*)(F.ctl + CW_BAR) + args.li * XCD_BAR_WORDS, F.MISC + 8);
#define GRID_BAR() xcd_barrier(bar)
    const int lo = args.ph_lo, hi = args.ph_hi;
#define IN(k) (lo <= (k) && (k) < hi)
#define BOTH(k) (IN(k) && IN((k) + 1))
    bf16* XB = (bf16*)(ws + WS_XB); bf16* UA = (bf16*)(ws + WS_UA); bf16* MIX = (bf16*)(ws + WS_MIX);
    float* SS0 = (float*)(ws + WS_SS0); float* SS1 = (float*)(ws + WS_SS1); float* SS2 = (float*)(ws + WS_SS2); float* SS3 = (float*)(ws + WS_SS3);

    if (IN(0)) { p0_prologue(F, args); if (BOTH(0)) GRID_BAR(); }
#if DUP == 10
    if (IN(0)) { p0_prologue(F, args); GRID_BAR(); }
#endif
    if (IN(1)) {
        pg8::Gemm g{XB, (const bf16*)(ws + WS_WGU1), M, 2 * FF, D}; pg8::StaticOrder S; S.init(M, 2 * FF, F.G, (int)blockIdx.x);
        pg8::EpiSwiGLU E{UA, FF, SS0};
        pg8::gemm_phase<pg8::EpiSwiGLU, pg8::StaticOrder, true, true>(F.lds + RING_OFF, g, S, E);
        if (BOTH(1)) GRID_BAR();
#if DUP == 1
        pg8::gemm_phase<pg8::EpiSwiGLU, pg8::StaticOrder, true, true>(F.lds + RING_OFF, g, S, E); GRID_BAR();
#endif
    }
    if (IN(2)) {
        pg8::Gemm g{UA, (const bf16*)(ws + WS_WD1), M, D, FF}; pg8::StaticOrder S; S.init(M, D, F.G, (int)blockIdx.x);
        pg8::EpiResid<true> E{args.in[0], args.out, XB, 0.5f, SS1};
        pg8::gemm_phase<pg8::EpiResid<true>, pg8::StaticOrder, true, true>(F.lds + RING_OFF, g, S, E);
        if (BOTH(2)) GRID_BAR();
    }
    if (IN(3)) {
        pg8::Gemm g{XB, (const bf16*)(ws + WS_WIN), M, NIN, D}; pg8::StaticOrder S; S.init(M, NIN, F.G, (int)blockIdx.x);
        pg8::EpiUProj E{UA, SS1, (const float*)(ws + WS_COS), (const float*)(ws + WS_SIN)};
        pg8::gemm_phase<pg8::EpiUProj, pg8::StaticOrder, true, true>(F.lds + RING_OFF, g, S, E);
        if (BOTH(3)) GRID_BAR();
#if DUP == 3
        pg8::gemm_phase<pg8::EpiUProj, pg8::StaticOrder, true, true>(F.lds + RING_OFF, g, S, E); GRID_BAR();
#endif
    }
    if (IN(4)) {
        mixer_phase(F, args, bar);
        if (BOTH(4)) GRID_BAR();
#if DUP == 4
        mixer_phase(F, args, bar); GRID_BAR();
#endif
    }
    if (IN(5)) {
        pg8::Gemm g{MIX, (const bf16*)(ws + WS_WOUT), M, D, D}; pg8::StaticOrder S; S.init(M, D, F.G, (int)blockIdx.x);
        pg8::EpiResid<true> E{args.out, args.out, XB, 1.0f, SS2};
        pg8::gemm_phase<pg8::EpiResid<true>, pg8::StaticOrder, true, true>(F.lds + RING_OFF, g, S, E);
        if (BOTH(5)) GRID_BAR();
    }
    if (IN(6)) {
        pg8::Gemm g{XB, (const bf16*)(ws + WS_WGU2), M, 2 * FF, D}; pg8::StaticOrder S; S.init(M, 2 * FF, F.G, (int)blockIdx.x);
        pg8::EpiSwiGLU E{UA, FF, SS2};
        pg8::gemm_phase<pg8::EpiSwiGLU, pg8::StaticOrder, true, true>(F.lds + RING_OFF, g, S, E);
        if (BOTH(6)) GRID_BAR();
    }
    if (IN(7)) {
        pg8::Gemm g{UA, (const bf16*)(ws + WS_WD2), M, D, FF}; pg8::StaticOrder S; S.init(M, D, F.G, (int)blockIdx.x);
        pg8::EpiResid<false> E{args.out, args.out, nullptr, 0.5f, SS3};
        pg8::gemm_phase<pg8::EpiResid<false>, pg8::StaticOrder, true, true>(F.lds + RING_OFF, g, S, E);
        if (BOTH(7)) GRID_BAR();
    }
    if (IN(8)) { p8_final(F, args); }
#undef IN
#undef BOTH
}

extern "C" void kernel_launch(void* const* d_in, const int* in_sizes, int n_in, void* d_out, int out_size, void* d_ws, size_t ws_size, hipStream_t stream) {
    static int grid = 0;
    if (grid == 0) {
        if (n_in != 14 || in_sizes[0] != M * D || out_size != M * D || ws_size < WS_END) { fprintf(stderr, "kernel_launch: unexpected shapes (n_in %d, in0 %d, out %d, ws %zu)\n", n_in, n_in > 0 ? in_sizes[0] : -1, out_size, ws_size); grid = -1; return; }
        int dev = 0, cus = 0;
        if (hipGetDevice(&dev) != hipSuccess || hipDeviceGetAttribute(&cus, hipDeviceAttributeMultiprocessorCount, dev) != hipSuccess) { grid = -1; return; }
        if (hipFuncSetAttribute((const void*)mk_fwd, hipFuncAttributeMaxDynamicSharedMemorySize, LDS_BYTES) != hipSuccess) { fprintf(stderr, "kernel_launch: hipFuncSetAttribute failed\n"); grid = -1; return; }
        int per_cu = 0;
        if (hipOccupancyMaxActiveBlocksPerMultiprocessor(&per_cu, (const void*)mk_fwd, NWAVES * 64, LDS_BYTES) != hipSuccess || per_cu < 1) fprintf(stderr, "kernel_launch: occupancy query says %d\n", per_cu);
        (void)hipGetLastError();
        grid = cus;
    }
    if (grid < 0) return;
    (void)hipMemsetAsync((char*)d_ws + WS_CTL, 0, CTL_ZERO_BYTES, stream);
    Args a{};
    for (int i = 0; i < 14; ++i) a.in[i] = (const float*)d_in[i];
    a.out = (float*)d_out; a.ws = (unsigned char*)d_ws;
    unsigned char* ws = (unsigned char*)d_ws;
    a.ph_lo = 0; a.ph_hi = N_PHASES; a.li = 0;
    hipLaunchKernelGGL(mk_fwd, dim3(grid), dim3(NWAVES * 64), LDS_BYTES, stream, a);
}
```
